# Optimizing an MI355X kernel written in HIP

```python
import math
import jax, jax.numpy as jnp
from jax import lax
import numpy as np

D_MODEL = 1024
BATCH = 4
SEQ = 8192
DEPTH = 1

MEM_LEN = 256
HEAD_DIM = 64
NSA_HEADS = 8
NSA_KV_HEADS = 2
NSA_GROUP = NSA_HEADS // NSA_KV_HEADS
SB_HEADS = 8
MIX_WIDTH = (NSA_HEADS + SB_HEADS) * HEAD_DIM
CMP_LEN = 32
CMP_STRIDE = 16
CMP_HIDDEN = 256
SEL_BLOCK = 64
SEL_TOPK = 16
WINDOW = 512
Q_BLOCK = 128
ROT_DIM = HEAD_DIM // 4
ROPE_THETA = 500000.0
MEM_HEADS = 4
D_FF = 2816
NORM_EPS = 1e-6
NEG = -1e30
FORCE_SCORE = 1e4

KV_W = NSA_KV_HEADS * HEAD_DIM
IN_SPLITS = [NSA_HEADS * HEAD_DIM, KV_W, KV_W, KV_W, KV_W, KV_W, KV_W, NSA_HEADS * 3,
             SB_HEADS * HEAD_DIM, SB_HEADS * HEAD_DIM, SB_HEADS * HEAD_DIM]
IN_COLS = sum(IN_SPLITS)

kernel_name = "hymba_nsa_stickbreak_macaron_memory"


def rms_norm(x, g):
    x32 = x.astype(jnp.float32)
    y = x32 * lax.rsqrt(jnp.mean(x32 * x32, axis=-1, keepdims=True) + NORM_EPS)
    return (y * g.astype(jnp.float32)).astype(x.dtype)


def rope_angles(pos):
    freqs = ROPE_THETA ** (-jnp.arange(0, ROT_DIM, 2, dtype=jnp.float32) / ROT_DIM)
    return pos.astype(jnp.float32)[..., None] * freqs


def apply_rope(x, ang):
    half = ROT_DIM // 2
    x1, x2, xp = x[..., :half], x[..., half:ROT_DIM], x[..., ROT_DIM:]
    c = jnp.cos(ang).astype(x.dtype)
    s = jnp.sin(ang).astype(x.dtype)
    return jnp.concatenate([x1 * c - x2 * s, x2 * c + x1 * s, xp], axis=-1)


def masked_softmax(s, mask):
    s = jnp.where(mask, s.astype(jnp.float32), NEG)
    m = jnp.max(s, axis=-1, keepdims=True)
    p = jnp.where(mask, jnp.exp(s - m), 0.0)
    return p / jnp.maximum(jnp.sum(p, axis=-1, keepdims=True), 1e-30)


def swiglu(h, wg, wu, wd):
    return (jax.nn.silu(h @ wg) * (h @ wu)) @ wd


def overlap_matrix(n_cmp, n_sel):
    cs = np.arange(n_cmp)[:, None] * CMP_STRIDE
    ss = np.arange(n_sel)[None, :] * SEL_BLOCK
    ov = np.minimum(cs + CMP_LEN, ss + SEL_BLOCK) - np.maximum(cs, ss)
    return jnp.asarray(np.clip(ov, 0, None).astype(np.float32) / CMP_LEN)


def compress(t, pe, w1, w2):
    B, H, T, dk = t.shape
    ratio = CMP_LEN // CMP_STRIDE
    n_chunks = T // CMP_STRIDE
    n_cmp = n_chunks - ratio + 1
    chunks = t.reshape(B, H, n_chunks, CMP_STRIDE, dk)
    blocks = jnp.concatenate([chunks[:, :, r:r + n_cmp] for r in range(ratio)], axis=3)
    blocks = blocks + pe
    flat = blocks.reshape(B, H, n_cmp, CMP_LEN * dk)
    return jax.nn.gelu(flat @ w1) @ w2


def nsa_mixer(q, k_cmp, v_cmp, k_sel, v_sel, k_win, v_win, gates, pos,
              pe_k, w1_k, w2_k, pe_v, w1_v, w2_v, g_q, g_kc, g_ks, g_kw):
    B, T = q.shape[:2]
    dk = HEAD_DIM
    scale = dk ** -0.5
    ang = rope_angles(pos)
    q = q.reshape(B, T, NSA_KV_HEADS, NSA_GROUP, dk).transpose(0, 2, 3, 1, 4)
    q = apply_rope(rms_norm(q, g_q), ang[:, None, None])

    def heads(t):
        return t.reshape(B, T, NSA_KV_HEADS, dk).transpose(0, 2, 1, 3)

    n_cmp = (T - CMP_LEN) // CMP_STRIDE + 1
    cmp_end = jnp.arange(n_cmp) * CMP_STRIDE + CMP_LEN - 1
    ang_c = rope_angles(pos[:, cmp_end])
    kc = apply_rope(rms_norm(compress(heads(k_cmp), pe_k, w1_k, w2_k), g_kc), ang_c[:, None])
    vc = compress(heads(v_cmp), pe_v, w1_v, w2_v)
    n_sel = T // SEL_BLOCK
    top_n = min(SEL_TOPK, n_sel)
    ks_blocks = apply_rope(rms_norm(heads(k_sel), g_ks), ang[:, None]).reshape(B, NSA_KV_HEADS, n_sel, SEL_BLOCK, dk)
    vs_blocks = heads(v_sel).reshape(B, NSA_KV_HEADS, n_sel, SEL_BLOCK, dk)
    w_ov = overlap_matrix(n_cmp, n_sel)
    pad = ((0, 0), (0, 0), (WINDOW, 0), (0, 0))
    kw_pad = jnp.pad(apply_rope(rms_norm(heads(k_win), g_kw), ang[:, None]), pad)
    vw_pad = jnp.pad(heads(v_win), pad)
    gates = jax.nn.sigmoid(gates.reshape(B, T, NSA_KV_HEADS, NSA_GROUP, 3).transpose(0, 2, 3, 1, 4))

    bi = jnp.arange(B)[:, None, None, None]
    hi = jnp.arange(NSA_KV_HEADS)[None, :, None, None]
    jblk = jnp.arange(n_sel)

    def block_fn(i):
        s0 = i * Q_BLOCK
        tq = s0 + jnp.arange(Q_BLOCK)
        qb = lax.dynamic_slice_in_dim(q, s0, Q_BLOCK, axis=3)
        gb = lax.dynamic_slice_in_dim(gates, s0, Q_BLOCK, axis=3)
        m_c = cmp_end[None, :] <= tq[:, None]
        p_c = masked_softmax(jnp.einsum('bhgqd,bhnd->bhgqn', qb, kc) * scale, m_c)
        o_c = jnp.einsum('bhgqn,bhnd->bhgqd', p_c, vc)
        imp = jnp.einsum('bhgqn,nj->bhqj', p_c, w_ov)
        cur = tq // SEL_BLOCK
        valid = jblk[None, :] * SEL_BLOCK <= tq[:, None]
        forced = (jblk[None, :] == 0) | (jblk[None, :] == cur[:, None]) | (jblk[None, :] == cur[:, None] - 1)
        score = jnp.where(valid & forced, FORCE_SCORE, jnp.where(valid, imp, -1.0))
        _, idx = lax.top_k(score, top_n)
        ksb = ks_blocks[bi, hi, idx].reshape(B, NSA_KV_HEADS, Q_BLOCK, top_n * SEL_BLOCK, dk)
        vsb = vs_blocks[bi, hi, idx].reshape(B, NSA_KV_HEADS, Q_BLOCK, top_n * SEL_BLOCK, dk)
        kpos = (idx[..., None] * SEL_BLOCK + jnp.arange(SEL_BLOCK)).reshape(B, NSA_KV_HEADS, Q_BLOCK, -1)
        m_s = (kpos <= tq[:, None])[:, :, None]
        p_s = masked_softmax(jnp.einsum('bhgqd,bhqkd->bhgqk', qb, ksb) * scale, m_s)
        o_s = jnp.einsum('bhgqk,bhqkd->bhgqd', p_s, vsb)
        kwb = lax.dynamic_slice_in_dim(kw_pad, s0, Q_BLOCK + WINDOW, axis=2)
        vwb = lax.dynamic_slice_in_dim(vw_pad, s0, Q_BLOCK + WINDOW, axis=2)
        kpos_w = s0 - WINDOW + jnp.arange(Q_BLOCK + WINDOW)
        diff = tq[:, None] - kpos_w[None, :]
        m_w = (kpos_w[None, :] >= 0) & (diff >= 0) & (diff < WINDOW)
        p_w = masked_softmax(jnp.einsum('bhgqd,bhkd->bhgqk', qb, kwb) * scale, m_w)
        o_w = jnp.einsum('bhgqk,bhkd->bhgqd', p_w, vwb)
        o = gb[..., 0:1] * o_c + gb[..., 1:2] * o_s + gb[..., 2:3] * o_w
        return o.astype(q.dtype)

    out = lax.map(block_fn, jnp.arange(T // Q_BLOCK))
    return out.transpose(1, 0, 4, 2, 3, 5).reshape(B, T, NSA_HEADS * dk)


def stick_breaking(q, k, v):
    B, T = q.shape[:2]
    dk = HEAD_DIM
    scale = dk ** -0.5

    def heads(t):
        return t.reshape(B, T, SB_HEADS, dk).transpose(0, 2, 1, 3)

    q, k, v = heads(q), heads(k), heads(v)
    kpos = jnp.arange(T)

    def block_fn(i):
        s0 = i * Q_BLOCK
        tq = s0 + jnp.arange(Q_BLOCK)
        qb = lax.dynamic_slice_in_dim(q, s0, Q_BLOCK, axis=2)
        z = jnp.einsum('bhqd,bhkd->bhqk', qb, k).astype(jnp.float32) * scale
        mask = kpos[None, :] < tq[:, None]
        log_rem = jnp.where(mask, jax.nn.log_sigmoid(-z), 0.0)
        suffix = lax.cumsum(log_rem, axis=3, reverse=True) - log_rem
        a = jnp.where(mask, jnp.exp(jax.nn.log_sigmoid(z) + suffix), 0.0)
        return jnp.einsum('bhqk,bhkd->bhqd', a, v).astype(q.dtype)

    out = lax.map(block_fn, jnp.arange(T // Q_BLOCK))
    return out.transpose(1, 0, 3, 2, 4).reshape(B, T, SB_HEADS * dk)


def memory_cross_attention(h, mem_n, wq, wk, wv, wo, g_q, g_k):
    B, T = h.shape[:2]
    M = mem_n.shape[1]
    q = rms_norm((h @ wq).reshape(B, T, MEM_HEADS, HEAD_DIM), g_q)
    k = rms_norm((mem_n @ wk).reshape(B, M, MEM_HEADS, HEAD_DIM), g_k)
    v = (mem_n @ wv).reshape(B, M, MEM_HEADS, HEAD_DIM)
    s = jnp.einsum('bqhd,bkhd->bhqk', q, k).astype(jnp.float32) * HEAD_DIM ** -0.5
    p = jax.nn.softmax(s, axis=-1)
    o = jnp.einsum('bhqk,bkhd->bqhd', p, v).astype(h.dtype).reshape(B, T, MEM_HEADS * HEAD_DIM)
    return o @ wo


def setup_inputs(seed: int = 0) -> dict:
    key = jax.random.key(seed)
    ks = iter(jax.random.split(key, 40))

    def dense(shape, fan_in):
        return jax.random.normal(next(ks), (DEPTH,) + shape, jnp.float32) * fan_in ** -0.5

    def gain(n):
        return 1.0 + 0.05 * jax.random.normal(next(ks), (DEPTH, n), jnp.float32)

    x = jax.random.normal(next(ks), (BATCH, SEQ, D_MODEL), jnp.float32)
    mem = jax.random.normal(next(ks), (BATCH, MEM_LEN, D_MODEL), jnp.float32)
    start = jax.random.randint(next(ks), (BATCH, 1), 0, 4096, dtype=jnp.int32)
    positions = (start + jnp.arange(SEQ, dtype=jnp.int32)[None, :]).astype(jnp.int32)
    return {
        "x": x, "mem": mem, "positions": positions,
        "ffn1_norm": gain(D_MODEL),
        "ffn1_wg": dense((D_MODEL, D_FF), D_MODEL),
        "ffn1_wu": dense((D_MODEL, D_FF), D_MODEL),
        "ffn1_wd": dense((D_FF, D_MODEL), D_FF),
        "mix_norm": gain(D_MODEL),
        "w_in": dense((D_MODEL, IN_COLS), D_MODEL),
        "nsa_q_norm": gain(HEAD_DIM),
        "nsa_kc_norm": gain(HEAD_DIM),
        "nsa_ks_norm": gain(HEAD_DIM),
        "nsa_kw_norm": gain(HEAD_DIM),
        "cmp_pos_k": 0.1 * jax.random.normal(next(ks), (DEPTH, CMP_LEN, HEAD_DIM), jnp.float32),
        "cmp_w1_k": dense((CMP_LEN * HEAD_DIM, CMP_HIDDEN), CMP_LEN * HEAD_DIM),
        "cmp_w2_k": dense((CMP_HIDDEN, HEAD_DIM), CMP_HIDDEN),
        "cmp_pos_v": 0.1 * jax.random.normal(next(ks), (DEPTH, CMP_LEN, HEAD_DIM), jnp.float32),
        "cmp_w1_v": dense((CMP_LEN * HEAD_DIM, CMP_HIDDEN), CMP_LEN * HEAD_DIM),
        "cmp_w2_v": dense((CMP_HIDDEN, HEAD_DIM), CMP_HIDDEN),
        "w_out": dense((MIX_WIDTH, D_MODEL), MIX_WIDTH),
        "mem_x_norm": gain(D_MODEL),
        "mem_kv_norm": gain(D_MODEL),
        "mem_wq": dense((D_MODEL, MEM_HEADS * HEAD_DIM), D_MODEL),
        "mem_wk": dense((D_MODEL, MEM_HEADS * HEAD_DIM), D_MODEL),
        "mem_wv": dense((D_MODEL, MEM_HEADS * HEAD_DIM), D_MODEL),
        "mem_q_norm": gain(HEAD_DIM),
        "mem_k_norm": gain(HEAD_DIM),
        "mem_wo": dense((MEM_HEADS * HEAD_DIM, D_MODEL), MEM_HEADS * HEAD_DIM),
        "ffn2_norm": gain(D_MODEL),
        "ffn2_wg": dense((D_MODEL, D_FF), D_MODEL),
        "ffn2_wu": dense((D_MODEL, D_FF), D_MODEL),
        "ffn2_wd": dense((D_FF, D_MODEL), D_FF),
    }


def reference(x, mem, positions, ffn1_norm, ffn1_wg, ffn1_wu, ffn1_wd, mix_norm, w_in,
              nsa_q_norm, nsa_kc_norm, nsa_ks_norm, nsa_kw_norm,
              cmp_pos_k, cmp_w1_k, cmp_w2_k, cmp_pos_v, cmp_w1_v, cmp_w2_v, w_out,
              mem_x_norm, mem_kv_norm, mem_wq, mem_wk, mem_wv, mem_q_norm, mem_k_norm, mem_wo,
              ffn2_norm, ffn2_wg, ffn2_wu, ffn2_wd):
    split_at = [int(c) for c in np.cumsum(IN_SPLITS)[:-1]]
    for l in range(DEPTH):
        x = x + 0.5 * swiglu(rms_norm(x, ffn1_norm[l]), ffn1_wg[l], ffn1_wu[l], ffn1_wd[l])
        h = rms_norm(x, mix_norm[l])
        (q_n, kc, vc, ksl, vsl, kwn, vwn, gts, q_s, k_s, v_s) = jnp.split(h @ w_in[l], split_at, axis=-1)
        o_nsa = nsa_mixer(q_n, kc, vc, ksl, vsl, kwn, vwn, gts, positions,
                          cmp_pos_k[l], cmp_w1_k[l], cmp_w2_k[l], cmp_pos_v[l], cmp_w1_v[l], cmp_w2_v[l],
                          nsa_q_norm[l], nsa_kc_norm[l], nsa_ks_norm[l], nsa_kw_norm[l])
        o_sb = stick_breaking(q_s, k_s, v_s)
        x = x + jnp.concatenate([o_nsa, o_sb], axis=-1) @ w_out[l]
        x = x + memory_cross_attention(rms_norm(x, mem_x_norm[l]), rms_norm(mem, mem_kv_norm[l]),
                                       mem_wq[l], mem_wk[l], mem_wv[l], mem_wo[l],
                                       mem_q_norm[l], mem_k_norm[l])
        x = x + 0.5 * swiglu(rms_norm(x, ffn2_norm[l]), ffn2_wg[l], ffn2_wu[l], ffn2_wd[l])
    return x
```

```cpp
#include <hip/hip_runtime.h>
#include <hip/hip_cooperative_groups.h>
#include <cstdio>
#include <cstdint>
#include <cmath>
namespace cg = cooperative_groups;

constexpr int B_ = 4, T_ = 8192, D_ = 1024, NT = B_ * T_;
constexpr int MEM_ = 256, NMEM = B_ * MEM_;
constexpr int FF = 2816, INC = 2840;
constexpr int NCMP = 511, NSELB = 128;
constexpr float EPS = 1e-6f;
constexpr int NTHR = 512, NWV = 8;
constexpr int C_QN = 0, C_KC = 512, C_VC = 640, C_KS = 768, C_VS = 896, C_KW = 1024, C_VW = 1152, C_GT = 1280, C_QS = 1304, C_KSB = 1816, C_VSB = 2328;

constexpr size_t RA_OFF = 0;
constexpr size_t RA_BYTES = (size_t)NT * INC * 4;
constexpr size_t RB_OFF = RA_OFF + RA_BYTES;
constexpr size_t RB_BYTES = (size_t)NT * D_ * 4;
constexpr size_t RC_OFF = RB_OFF + RB_BYTES;
constexpr size_t RC_ROPEC = RC_OFF;
constexpr size_t RC_ROPES = RC_ROPEC + (size_t)NT * 8 * 4;
constexpr size_t RC_MEMN = RC_ROPES + (size_t)NT * 8 * 4;
constexpr size_t RC_KMEM = RC_MEMN + (size_t)NMEM * D_ * 4;
constexpr size_t RC_VMEM = RC_KMEM + (size_t)NMEM * 256 * 4;
constexpr size_t RC_HC = RC_VMEM + (size_t)NMEM * 256 * 4;
constexpr size_t RC_KC = RC_HC + (size_t)2 * 8 * 512 * 256 * 4;
constexpr size_t RC_VC = RC_KC + (size_t)8 * 512 * 64 * 4;
constexpr size_t RC_END = RC_VC + (size_t)8 * 512 * 64 * 4;
constexpr size_t WS_NEED = RC_END;

struct Params {
    const float* in[32];
    const int* pos;
    float* out;
    unsigned char* ws;
};

__device__ __forceinline__ float wave_sum(float v) {
#pragma unroll
    for (int o = 1; o < 64; o <<= 1) v += __shfl_xor(v, o);
    return v;
}
__device__ __forceinline__ float wave_max(float v) {
#pragma unroll
    for (int o = 1; o < 64; o <<= 1) v = fmaxf(v, __shfl_xor(v, o));
    return v;
}
#define LDS_FENCE() do { asm volatile("s_waitcnt lgkmcnt(0)" ::: "memory"); __builtin_amdgcn_wave_barrier(); } while (0)

__device__ __forceinline__ void sincos_acc(float ang, float& s, float& c) {
    const double a = (double)ang;
    const double k = rint(a * 0.63661977236758134308);
    const double r = fma(-k, 1.57079632679489661923, a) - k * 6.123233995736766e-17;
    const double r2 = r * r;
    double sp = r * (1.0 + r2 * (-1.0 / 6 + r2 * (1.0 / 120 + r2 * (-1.0 / 5040 + r2 * (1.0 / 362880 + r2 * (-1.0 / 39916800 + r2 * (1.0 / 6227020800.0)))))));
    double cp = 1.0 + r2 * (-0.5 + r2 * (1.0 / 24 + r2 * (-1.0 / 720 + r2 * (1.0 / 40320 + r2 * (-1.0 / 3628800 + r2 * (1.0 / 479001600.0 + r2 * (-1.0 / 87178291200.0)))))));
    const int q = ((int)k) & 3;
    double ss = (q & 1) ? cp : sp, cc = (q & 1) ? sp : cp;
    if (q == 1) cc = -cc; else if (q == 2) { ss = -ss; cc = -cc; } else if (q == 3) ss = -ss;
    s = (float)ss; c = (float)cc;
}
__device__ __forceinline__ float gelu_tanh(float x) { return 0.5f * x * (1.0f + tanhf(0.7978845608028654f * (x + 0.044715f * x * x * x))); }
__device__ __forceinline__ float sigmoidf_(float x) { return 1.0f / (1.0f + expf(-x)); }
__device__ __forceinline__ float softplusf_(float z) { return fmaxf(z, 0.f) + log1pf(expf(-fabsf(z))); }

__constant__ float ROPE_FREQ[8] = {1.0f, 0.19392274f, 0.03760603f, 0.0072926646f, 0.0014142136f, 0.0002742482f, 5.3182957e-05f, 1.0313385e-05f};

__device__ void ph_rmsnorm(const float* X, const float* g, float* O, int rows) {
    const int lane = threadIdx.x & 63, wv = threadIdx.x >> 6;
    for (int r = blockIdx.x * NWV + wv; r < rows; r += gridDim.x * NWV) {
        const float4* xr = (const float4*)(X + (size_t)r * D_);
        float4 v[4]; float ss = 0.f;
#pragma unroll
        for (int j = 0; j < 4; ++j) { v[j] = xr[lane + 64 * j]; ss += v[j].x * v[j].x + v[j].y * v[j].y + v[j].z * v[j].z + v[j].w * v[j].w; }
        const float rs = rsqrtf(wave_sum(ss) * (1.f / D_) + EPS);
        float4* orow = (float4*)(O + (size_t)r * D_);
#pragma unroll
        for (int j = 0; j < 4; ++j) { const float4 gg = ((const float4*)g)[lane + 64 * j]; float4 o; o.x = v[j].x * rs * gg.x; o.y = v[j].y * rs * gg.y; o.z = v[j].z * rs * gg.z; o.w = v[j].w * rs * gg.w; orow[lane + 64 * j] = o; }
    }
}

template <bool DUAL, class Epi>
__device__ void gemm_naive(float* lds, const float* A, int lda, const float* W, const float* W2, int ldw, int M, int N, int K, const Epi& epi) {
    float* As = lds; float* Bs = lds + 16 * 132; float* B2s = Bs + 16 * 128;
    const int tid = threadIdx.x, tx = tid & 31, ty = tid >> 5;
    const int ntm = M / 128, ntn = (N + 127) / 128;
    for (int tile = blockIdx.x; tile < ntm * ntn; tile += gridDim.x) {
        const int tm = tile / ntn, tn = tile % ntn;
        float acc[8][4], acc2[8][4];
#pragma unroll
        for (int i = 0; i < 8; ++i)
#pragma unroll
            for (int j = 0; j < 4; ++j) { acc[i][j] = 0.f; acc2[i][j] = 0.f; }
        for (int k0 = 0; k0 < K; k0 += 16) {
            {
                const int r = tid >> 2, kq = (tid & 3) * 4;
                const float4 v = *(const float4*)(A + (size_t)(tm * 128 + r) * lda + k0 + kq);
                As[(kq + 0) * 132 + r] = v.x; As[(kq + 1) * 132 + r] = v.y; As[(kq + 2) * 132 + r] = v.z; As[(kq + 3) * 132 + r] = v.w;
            }
            {
                const int kk = tid >> 5, n = (tid & 31) * 4, gn = tn * 128 + n;
                float4 v = {0.f, 0.f, 0.f, 0.f}, v2 = {0.f, 0.f, 0.f, 0.f};
                if (gn < N) { v = *(const float4*)(W + (size_t)(k0 + kk) * ldw + gn); if (DUAL) v2 = *(const float4*)(W2 + (size_t)(k0 + kk) * ldw + gn); }
                *(float4*)(Bs + kk * 128 + n) = v;
                if (DUAL) *(float4*)(B2s + kk * 128 + n) = v2;
            }
            __syncthreads();
#pragma unroll
            for (int kk = 0; kk < 16; ++kk) {
                const float4 a0 = *(const float4*)(As + kk * 132 + ty * 8), a1 = *(const float4*)(As + kk * 132 + ty * 8 + 4);
                const float4 bq = *(const float4*)(Bs + kk * 128 + tx * 4);
                const float a[8] = {a0.x, a0.y, a0.z, a0.w, a1.x, a1.y, a1.z, a1.w};
                const float b[4] = {bq.x, bq.y, bq.z, bq.w};
#pragma unroll
                for (int i = 0; i < 8; ++i)
#pragma unroll
                    for (int j = 0; j < 4; ++j) acc[i][j] = fmaf(a[i], b[j], acc[i][j]);
                if (DUAL) {
                    const float4 cq = *(const float4*)(B2s + kk * 128 + tx * 4);
                    const float c[4] = {cq.x, cq.y, cq.z, cq.w};
#pragma unroll
                    for (int i = 0; i < 8; ++i)
#pragma unroll
                        for (int j = 0; j < 4; ++j) acc2[i][j] = fmaf(a[i], c[j], acc2[i][j]);
                }
            }
            __syncthreads();
        }
        const int col = tn * 128 + tx * 4;
        if (col < N) {
#pragma unroll
            for (int i = 0; i < 8; ++i) epi(tm * 128 + ty * 8 + i, col, acc[i], acc2[i]);
        }
    }
}

struct EpiSwiglu { float* O; int ldo;
    __device__ void operator()(int r, int c, const float (&a)[4], const float (&b)[4]) const {
        float4 o; o.x = a[0] * sigmoidf_(a[0]) * b[0]; o.y = a[1] * sigmoidf_(a[1]) * b[1]; o.z = a[2] * sigmoidf_(a[2]) * b[2]; o.w = a[3] * sigmoidf_(a[3]) * b[3];
        *(float4*)(O + (size_t)r * ldo + c) = o; } };
struct EpiStore { float* O; int ldo;
    __device__ void operator()(int r, int c, const float (&a)[4], const float (&)[4]) const { float4 o = {a[0], a[1], a[2], a[3]}; *(float4*)(O + (size_t)r * ldo + c) = o; } };
struct EpiResid { const float* base; float* O; int ldo; float alpha;
    __device__ void operator()(int r, int c, const float (&a)[4], const float (&)[4]) const {
        const float4 bv = *(const float4*)(base + (size_t)r * ldo + c); float4 o = {bv.x + alpha * a[0], bv.y + alpha * a[1], bv.z + alpha * a[2], bv.w + alpha * a[3]};
        *(float4*)(O + (size_t)r * ldo + c) = o; } };

__device__ void ph_prep(const Params& p) {
    float* rc = (float*)(p.ws + RC_ROPEC); float* rs = (float*)(p.ws + RC_ROPES);
    for (int i = blockIdx.x * NTHR + threadIdx.x; i < NT * 8; i += gridDim.x * NTHR) {
        const int m = i >> 3, f = i & 7;
        const float ang = (float)p.pos[m] * ROPE_FREQ[f];
        float s, c; sincos_acc(ang, s, c); rc[i] = c; rs[i] = s;
    }
    ph_rmsnorm(p.in[1], p.in[21], (float*)(p.ws + RC_MEMN), NMEM);
}

__device__ void ph_postproj(const Params& p) {
    float* PROJ = (float*)(p.ws + RA_OFF);
    const float* rc = (const float*)(p.ws + RC_ROPEC); const float* rs = (const float*)(p.ws + RC_ROPES);
    const int lane = threadIdx.x & 63, wv = threadIdx.x >> 6;
    for (int it = blockIdx.x * NWV + wv; it < NT * 13; it += gridDim.x * NWV) {
        const int m = it / 13, slot = it % 13;
        float* row = PROJ + (size_t)m * INC;
        if (slot == 12) { if (lane < 24) row[C_GT + lane] = sigmoidf_(row[C_GT + lane]); continue; }
        int col; const float* g;
        if (slot < 8) { col = C_QN + slot * 64; g = p.in[9]; } else if (slot < 10) { col = C_KS + (slot - 8) * 64; g = p.in[11]; } else { col = C_KW + (slot - 10) * 64; g = p.in[12]; }
        const float v = row[col + lane];
        const float r = rsqrtf(wave_sum(v * v) * (1.f / 64.f) + EPS);
        float y = v * r * g[lane];
        const float yp = __shfl_xor(y, 8);
        if (lane < 16) { const float c = rc[m * 8 + (lane & 7)], s = rs[m * 8 + (lane & 7)]; y = (lane < 8) ? (y * c - yp * s) : (y * c + yp * s); }
        row[col + lane] = y;
    }
}

__device__ void ph_cmp1(const Params& p, float* lds) {
    const float* PROJ = (const float*)(p.ws + RA_OFF);
    float* HC = (float*)(p.ws + RC_HC);
    const int tid = threadIdx.x, half = tid >> 8, j = tid & 255;
    float* fl = lds + half * 2048;
    const int nitems = 2 * 8 * NCMP;
    for (int it0 = blockIdx.x * 2; it0 < nitems; it0 += gridDim.x * 2) {
        const int it = it0 + half; const bool ok = it < nitems;
        const int kv = ok ? it / (8 * NCMP) : 0, rem = ok ? it % (8 * NCMP) : 0, bh = rem / NCMP, n = rem % NCMP, b = bh >> 1, hk = bh & 1;
        const float* pe = kv ? p.in[16] : p.in[13]; const float* w1 = kv ? p.in[17] : p.in[14];
        const int colb = (kv ? C_VC : C_KC) + hk * 64;
        __syncthreads();
        for (int k = j; k < 2048; k += 256) { const int tok = k >> 6, d = k & 63; fl[k] = PROJ[(size_t)(b * T_ + 16 * n + tok) * INC + colb + d] + pe[k]; }
        __syncthreads();
        if (ok) {
            float acc = 0.f;
            for (int k = 0; k < 2048; ++k) acc = fmaf(fl[k], w1[(size_t)k * 256 + j], acc);
            HC[((size_t)(kv * 8 + bh) * 512 + n) * 256 + j] = gelu_tanh(acc);
        }
    }
}
__device__ void ph_cmp2(const Params& p) {
    const float* HC = (const float*)(p.ws + RC_HC);
    float* KC = (float*)(p.ws + RC_KC); float* VC = (float*)(p.ws + RC_VC);
    const float* rc = (const float*)(p.ws + RC_ROPEC); const float* rs = (const float*)(p.ws + RC_ROPES);
    const int lane = threadIdx.x & 63, wv = threadIdx.x >> 6;
    for (int it = blockIdx.x * NWV + wv; it < 2 * 8 * NCMP; it += gridDim.x * NWV) {
        const int kv = it / (8 * NCMP), rem = it % (8 * NCMP), bh = rem / NCMP, n = rem % NCMP, b = bh >> 1;
        const float* w2 = kv ? p.in[18] : p.in[15];
        const float* h = HC + ((size_t)(kv * 8 + bh) * 512 + n) * 256;
        float acc = 0.f;
        for (int jj = 0; jj < 256; ++jj) acc = fmaf(h[jj], w2[jj * 64 + lane], acc);
        if (kv) { VC[((size_t)bh * 512 + n) * 64 + lane] = acc; continue; }
        const float r = rsqrtf(wave_sum(acc * acc) * (1.f / 64.f) + EPS);
        float y = acc * r * p.in[10][lane];
        const float yp = __shfl_xor(y, 8);
        const int m = b * T_ + 16 * n + 31;
        if (lane < 16) { const float c = rc[m * 8 + (lane & 7)], s = rs[m * 8 + (lane & 7)]; y = (lane < 8) ? (y * c - yp * s) : (y * c + yp * s); }
        KC[((size_t)bh * 512 + n) * 64 + lane] = y;
    }
}

__device__ void ph_nsa(const Params& p, float* lds) {
    const float* PROJ = (const float*)(p.ws + RA_OFF);
    const float* KC = (const float*)(p.ws + RC_KC); const float* VC = (const float*)(p.ws + RC_VC);
    float* MIX = (float*)(p.ws + RB_OFF);
    const int lane = threadIdx.x & 63, wv = threadIdx.x >> 6;
    float* PW = lds + wv * (4 * 512 + 256);
    float* QL = PW + 4 * 512;
    const float scale = 0.125f;
    for (int it = blockIdx.x * NWV + wv; it < B_ * 2 * T_; it += gridDim.x * NWV) {
        const int t = it % T_, bh = it / T_, b = bh >> 1, hk = bh & 1;
        const int m = b * T_ + t;
        const float* prow = PROJ + (size_t)m * INC;
        LDS_FENCE();
#pragma unroll
        for (int g = 0; g < 4; ++g) QL[g * 64 + lane] = prow[C_QN + hk * 256 + g * 64 + lane];
        LDS_FENCE();
        const int nvis = t >= 31 ? (t - 31) / 16 + 1 : 0;
        float oc[4] = {0.f, 0.f, 0.f, 0.f};
        {
            float sc[8][4];
#pragma unroll
            for (int c = 0; c < 8; ++c) {
                const int n = c * 64 + lane;
#pragma unroll
                for (int g = 0; g < 4; ++g) sc[c][g] = -INFINITY;
                if (n < nvis) {
                    const float* kr = KC + ((size_t)bh * 512 + n) * 64;
                    float a0 = 0.f, a1 = 0.f, a2 = 0.f, a3 = 0.f;
                    for (int d = 0; d < 64; ++d) { const float kd = kr[d]; a0 = fmaf(QL[d], kd, a0); a1 = fmaf(QL[64 + d], kd, a1); a2 = fmaf(QL[128 + d], kd, a2); a3 = fmaf(QL[192 + d], kd, a3); }
                    sc[c][0] = a0 * scale; sc[c][1] = a1 * scale; sc[c][2] = a2 * scale; sc[c][3] = a3 * scale;
                }
            }
#pragma unroll
            for (int g = 0; g < 4; ++g) {
                float mx = -INFINITY;
#pragma unroll
                for (int c = 0; c < 8; ++c) mx = fmaxf(mx, sc[c][g]);
                mx = wave_max(mx);
                float sm = 0.f;
#pragma unroll
                for (int c = 0; c < 8; ++c) { const float e = (c * 64 + lane < nvis) ? expf(sc[c][g] - mx) : 0.f; sc[c][g] = e; sm += e; }
                sm = wave_sum(sm);
                const float inv = 1.0f / fmaxf(sm, 1e-30f);
#pragma unroll
                for (int c = 0; c < 8; ++c) PW[g * 512 + c * 64 + lane] = sc[c][g] * inv;
            }
            LDS_FENCE();
            for (int n = 0; n < nvis; ++n) {
                const float vv = VC[((size_t)bh * 512 + n) * 64 + lane];
#pragma unroll
                for (int g = 0; g < 4; ++g) oc[g] = fmaf(PW[g * 512 + n], vv, oc[g]);
            }
        }
        const int cur = t >> 6;
        float sco[2];
#pragma unroll
        for (int u = 0; u < 2; ++u) {
            const int j = lane + 64 * u;
            float imp = 0.f;
#pragma unroll
            for (int g = 0; g < 4; ++g) {
                const float* P = PW + g * 512;
                imp += P[4 * j] + P[4 * j + 1] + P[4 * j + 2] + 0.5f * P[4 * j + 3] + (j > 0 ? 0.5f * P[4 * j - 1] : 0.f);
            }
            const bool valid = j <= cur, forced = (j == 0) || (j == cur) || (j == cur - 1);
            sco[u] = (valid && forced) ? 1e4f : (valid ? imp : -1.0f);
        }
        LDS_FENCE();
        int sel[16]; int nsel = 0;
#pragma unroll
        for (int r = 0; r < 16; ++r) {
            float bv; int bi;
            if (sco[0] >= sco[1]) { bv = sco[0]; bi = lane; } else { bv = sco[1]; bi = lane + 64; }
#pragma unroll
            for (int o = 1; o < 64; o <<= 1) { const float ov = __shfl_xor(bv, o); const int oi = __shfl_xor(bi, o); if (ov > bv || (ov == bv && oi < bi)) { bv = ov; bi = oi; } }
            sel[r] = (bv >= 0.f) ? bi : -1;
            if (bv >= 0.f) ++nsel;
            if (bi == lane) sco[0] = -2.f; if (bi == lane + 64) sco[1] = -2.f;
        }
        float os[4] = {0.f, 0.f, 0.f, 0.f};
        {
            float mx[4] = {-INFINITY, -INFINITY, -INFINITY, -INFINITY};
#pragma unroll 1
            for (int pass = 0; pass < 2; ++pass) {
                float sm[4] = {0.f, 0.f, 0.f, 0.f};
#pragma unroll
                for (int r = 0; r < 16; ++r) {
                    if (sel[r] < 0) continue;
                    const int key = sel[r] * 64 + lane;
                    float s4[4] = {-INFINITY, -INFINITY, -INFINITY, -INFINITY};
                    if (key <= t) {
                        const float* kr = PROJ + (size_t)(b * T_ + key) * INC + C_KS + hk * 64;
                        float a0 = 0.f, a1 = 0.f, a2 = 0.f, a3 = 0.f;
                        for (int d = 0; d < 64; ++d) { const float kd = kr[d]; a0 = fmaf(QL[d], kd, a0); a1 = fmaf(QL[64 + d], kd, a1); a2 = fmaf(QL[128 + d], kd, a2); a3 = fmaf(QL[192 + d], kd, a3); }
                        s4[0] = a0 * scale; s4[1] = a1 * scale; s4[2] = a2 * scale; s4[3] = a3 * scale;
                    }
                    if (pass == 0) {
#pragma unroll
                        for (int g = 0; g < 4; ++g) mx[g] = fmaxf(mx[g], s4[g]);
                    } else {
                        LDS_FENCE();
#pragma unroll
                        for (int g = 0; g < 4; ++g) { const float e = (key <= t) ? expf(s4[g] - mx[g]) : 0.f; sm[g] += e; PW[g * 512 + lane] = e; }
                        LDS_FENCE();
                        const int k0 = sel[r] * 64;
                        const int kend = min(63, t - k0);
                        for (int kk = 0; kk <= kend; ++kk) {
                            const float vv = PROJ[(size_t)(b * T_ + k0 + kk) * INC + C_VS + hk * 64 + lane];
#pragma unroll
                            for (int g = 0; g < 4; ++g) os[g] = fmaf(PW[g * 512 + kk], vv, os[g]);
                        }
                    }
                }
                if (pass == 0) {
#pragma unroll
                    for (int g = 0; g < 4; ++g) mx[g] = wave_max(mx[g]);
                } else {
#pragma unroll
                    for (int g = 0; g < 4; ++g) os[g] *= 1.0f / fmaxf(wave_sum(sm[g]), 1e-30f);
                }
            }
        }
        float ow[4] = {0.f, 0.f, 0.f, 0.f};
        {
            float ss[8][4];
#pragma unroll
            for (int c = 0; c < 8; ++c) {
#pragma unroll
                for (int g = 0; g < 4; ++g) ss[c][g] = -INFINITY;
                const int key = t - (c * 64 + lane);
                if (key >= 0) {
                    const float* kr = PROJ + (size_t)(b * T_ + key) * INC + C_KW + hk * 64;
                    float a0 = 0.f, a1 = 0.f, a2 = 0.f, a3 = 0.f;
                    for (int d = 0; d < 64; ++d) { const float kd = kr[d]; a0 = fmaf(QL[d], kd, a0); a1 = fmaf(QL[64 + d], kd, a1); a2 = fmaf(QL[128 + d], kd, a2); a3 = fmaf(QL[192 + d], kd, a3); }
                    ss[c][0] = a0 * scale; ss[c][1] = a1 * scale; ss[c][2] = a2 * scale; ss[c][3] = a3 * scale;
                }
            }
            float inv[4];
#pragma unroll
            for (int g = 0; g < 4; ++g) {
                float mx = -INFINITY;
#pragma unroll
                for (int c = 0; c < 8; ++c) mx = fmaxf(mx, ss[c][g]);
                mx = wave_max(mx);
                float sm = 0.f;
#pragma unroll
                for (int c = 0; c < 8; ++c) { const float e = (ss[c][g] > -INFINITY) ? expf(ss[c][g] - mx) : 0.f; ss[c][g] = e; sm += e; }
                sm = wave_sum(sm);
                inv[g] = 1.0f / fmaxf(sm, 1e-30f);
            }
#pragma unroll
            for (int c = 0; c < 8; ++c) {
                if (t - c * 64 < 0) continue;
                LDS_FENCE();
#pragma unroll
                for (int g = 0; g < 4; ++g) PW[g * 512 + lane] = ss[c][g] * inv[g];
                LDS_FENCE();
                const int kend = min(63, t - c * 64);
                for (int l = 0; l <= kend; ++l) {
                    const float vv = PROJ[(size_t)(b * T_ + t - (c * 64 + l)) * INC + C_VW + hk * 64 + lane];
#pragma unroll
                    for (int g = 0; g < 4; ++g) ow[g] = fmaf(PW[g * 512 + l], vv, ow[g]);
                }
            }
        }
#pragma unroll
        for (int g = 0; g < 4; ++g) {
            const float gc = prow[C_GT + hk * 12 + g * 3 + 0], gs = prow[C_GT + hk * 12 + g * 3 + 1], gw = prow[C_GT + hk * 12 + g * 3 + 2];
            MIX[(size_t)m * D_ + hk * 256 + g * 64 + lane] = gc * oc[g] + gs * os[g] + gw * ow[g];
        }
    }
}

__device__ void ph_sb(const Params& p, float* lds) {
    const float* PROJ = (const float*)(p.ws + RA_OFF);
    float* MIX = (float*)(p.ws + RB_OFF);
    const int lane = threadIdx.x & 63, wv = threadIdx.x >> 6;
    float* PW = lds + wv * 128; float* QL = PW + 64;
    for (int it = blockIdx.x * NWV + wv; it < B_ * 8 * T_; it += gridDim.x * NWV) {
        const int t = it % T_, bh = it / T_, b = bh >> 3, h = bh & 7;
        const int m = b * T_ + t;
        LDS_FENCE();
        QL[lane] = PROJ[(size_t)m * INC + C_QS + h * 64 + lane];
        LDS_FENCE();
        float o = 0.f, R = 0.f;
        for (int c0 = 0; c0 < t; c0 += 64) {
            const int s = t - 1 - (c0 + lane);
            const bool valid = s >= 0;
            float z = 0.f;
            if (valid) { const float* kr = PROJ + (size_t)(b * T_ + s) * INC + C_KSB + h * 64; float a = 0.f; for (int d = 0; d < 64; ++d) a = fmaf(QL[d], kr[d], a); z = a * 0.125f; }
            const float sp = softplusf_(z);
            const float lr = valid ? -sp : 0.f;
            float incl = lr;
#pragma unroll
            for (int off = 1; off < 64; off <<= 1) { const float n = __shfl_up(incl, off); if (lane >= off) incl += n; }
            const float suffix = R + (incl - lr);
            const float a = valid ? expf((z - sp) + suffix) : 0.f;
            LDS_FENCE();
            PW[lane] = a;
            LDS_FENCE();
            const int kend = min(63, t - 1 - c0);
            for (int l = 0; l <= kend; ++l) o = fmaf(PW[l], PROJ[(size_t)(b * T_ + t - 1 - (c0 + l)) * INC + C_VSB + h * 64 + lane], o);
            R += __shfl(incl, 63);
            if (R < -60.f) break;
        }
        MIX[(size_t)m * D_ + 512 + h * 64 + lane] = o;
    }
}

__device__ void ph_memk_norm(const Params& p) {
    float* KM = (float*)(p.ws + RC_KMEM);
    const int lane = threadIdx.x & 63, wv = threadIdx.x >> 6;
    for (int it = blockIdx.x * NWV + wv; it < NMEM * 4; it += gridDim.x * NWV) {
        const float v = KM[(size_t)it * 64 + lane];
        const float r = rsqrtf(wave_sum(v * v) * (1.f / 64.f) + EPS);
        KM[(size_t)it * 64 + lane] = v * r * p.in[26][lane];
    }
}
__device__ void ph_memattn(const Params& p, float* lds) {
    const float* QM = (const float*)(p.ws + RA_OFF);
    float* OM = (float*)(p.ws + RA_OFF + (size_t)NT * 256 * 4);
    const float* KM = (const float*)(p.ws + RC_KMEM); const float* VM = (const float*)(p.ws + RC_VMEM);
    const int lane = threadIdx.x & 63, wv = threadIdx.x >> 6;
    float* PW = lds + wv * 320; float* QL = PW + 256;
    for (int it = blockIdx.x * NWV + wv; it < NT * 4; it += gridDim.x * NWV) {
        const int m = it >> 2, h = it & 3, b = m / T_;
        const float v = QM[(size_t)m * 256 + h * 64 + lane];
        const float r = rsqrtf(wave_sum(v * v) * (1.f / 64.f) + EPS);
        LDS_FENCE();
        QL[lane] = v * r * p.in[25][lane];
        LDS_FENCE();
        float s[4]; float mx = -INFINITY;
#pragma unroll
        for (int c = 0; c < 4; ++c) { const float* kr = KM + (size_t)(b * MEM_ + c * 64 + lane) * 256 + h * 64; float a = 0.f; for (int d = 0; d < 64; ++d) a = fmaf(QL[d], kr[d], a); s[c] = a * 0.125f; mx = fmaxf(mx, s[c]); }
        mx = wave_max(mx);
        float sm = 0.f;
#pragma unroll
        for (int c = 0; c < 4; ++c) { s[c] = expf(s[c] - mx); sm += s[c]; }
        sm = wave_sum(sm);
        const float inv = 1.f / sm;
#pragma unroll
        for (int c = 0; c < 4; ++c) PW[c * 64 + lane] = s[c] * inv;
        LDS_FENCE();
        float o = 0.f;
        for (int k = 0; k < 256; ++k) o = fmaf(PW[k], VM[(size_t)(b * MEM_ + k) * 256 + h * 64 + lane], o);
        OM[(size_t)m * 256 + h * 64 + lane] = o;
    }
}

constexpr int NPH = 20;
template <int PHT> __global__ void __launch_bounds__(NTHR) mega(Params p) {
    extern __shared__ __attribute__((aligned(16))) float lds[];
    float* RA = (float*)(p.ws + RA_OFF); float* RB = (float*)(p.ws + RB_OFF);
    {
        constexpr int ph = PHT;
        switch (ph) {
        case 0: ph_prep(p); break;
        case 1: ph_rmsnorm(p.in[0], p.in[3], RB, NT); break;
        case 2: gemm_naive<true>(lds, RB, D_, p.in[4], p.in[5], FF, NT, FF, D_, EpiSwiglu{RA, FF}); break;
        case 3: gemm_naive<false>(lds, RA, FF, p.in[6], nullptr, D_, NT, D_, FF, EpiResid{p.in[0], p.out, D_, 0.5f}); break;
        case 4: ph_rmsnorm(p.out, p.in[7], RB, NT); break;
        case 5: gemm_naive<false>(lds, RB, D_, p.in[8], nullptr, INC, NT, INC, D_, EpiStore{RA, INC}); break;
        case 6: ph_postproj(p); break;
        case 7: ph_cmp1(p, lds); break;
        case 8: ph_cmp2(p); break;
        case 9: ph_nsa(p, lds); break;
        case 10: ph_sb(p, lds); break;
        case 11: gemm_naive<false>(lds, RB, D_, p.in[19], nullptr, D_, NT, D_, D_, EpiResid{p.out, p.out, D_, 1.0f}); break;
        case 12: ph_rmsnorm(p.out, p.in[20], RB, NT); break;
        case 13: gemm_naive<false>(lds, RB, D_, p.in[22], nullptr, 256, NT, 256, D_, EpiStore{RA, 256});
                 gemm_naive<false>(lds, (const float*)(p.ws + RC_MEMN), D_, p.in[23], nullptr, 256, NMEM, 256, D_, EpiStore{(float*)(p.ws + RC_KMEM), 256});
                 gemm_naive<false>(lds, (const float*)(p.ws + RC_MEMN), D_, p.in[24], nullptr, 256, NMEM, 256, D_, EpiStore{(float*)(p.ws + RC_VMEM), 256}); break;
        case 14: ph_memk_norm(p); break;
        case 15: ph_memattn(p, lds); break;
        case 16: gemm_naive<false>(lds, RA + (size_t)NT * 256, 256, p.in[27], nullptr, D_, NT, D_, 256, EpiResid{p.out, p.out, D_, 1.0f}); break;
        case 17: ph_rmsnorm(p.out, p.in[28], RB, NT); break;
        case 18: gemm_naive<true>(lds, RB, D_, p.in[29], p.in[30], FF, NT, FF, D_, EpiSwiglu{RA, FF}); break;
        case 19: gemm_naive<false>(lds, RA, FF, p.in[31], nullptr, D_, NT, D_, FF, EpiResid{p.out, p.out, D_, 0.5f}); break;
        default: break;
        }
    }
}

extern "C" void kernel_launch(void* const* d_in, const int* in_sizes, int n_in, void* d_out, int out_size, void* d_ws, size_t ws_size, hipStream_t stream) {
    if (n_in != 32 || ws_size < WS_NEED) { fprintf(stderr, "kernel_launch: unexpected n_in %d or ws_size %zu (need %zu)\n", n_in, ws_size, (size_t)WS_NEED); return; }
    Params p{};
    for (int i = 0; i < 32; ++i) p.in[i] = (const float*)d_in[i];
    p.pos = (const int*)d_in[2]; p.out = (float*)d_out; p.ws = (unsigned char*)d_ws;
    constexpr int LDS_BYTES = 80 * 1024;
#define LAUNCH_PH(PH) do { (void)hipFuncSetAttribute((const void*)mega<PH>, hipFuncAttributeMaxDynamicSharedMemorySize, LDS_BYTES); hipLaunchKernelGGL(mega<PH>, dim3(512), dim3(NTHR), LDS_BYTES, stream, p); } while (0)
    LAUNCH_PH(0); LAUNCH_PH(1); LAUNCH_PH(2); LAUNCH_PH(3); LAUNCH_PH(4); LAUNCH_PH(5); LAUNCH_PH(6); LAUNCH_PH(7); LAUNCH_PH(8); LAUNCH_PH(9);
    LAUNCH_PH(10); LAUNCH_PH(11); LAUNCH_PH(12); LAUNCH_PH(13); LAUNCH_PH(14); LAUNCH_PH(15); LAUNCH_PH(16); LAUNCH_PH(17); LAUNCH_PH(18); LAUNCH_PH(19);
}
```

```cpp
#include <hip/hip_runtime.h>
#include <hip/hip_cooperative_groups.h>
#include <cstdio>
#include <cstdint>
#include <cmath>
namespace cg = cooperative_groups;

constexpr int B_ = 4, T_ = 8192, D_ = 1024, NT = B_ * T_;
constexpr int MEM_ = 256, NMEM = B_ * MEM_;
constexpr int FF = 2816, INC = 2840, INP = 3072;
constexpr int NCMP = 511;
constexpr float EPS = 1e-6f;
constexpr float Q_SCALE = 0.125f * 1.4426950408889634f;
constexpr int NTHR = 512, NWV = 8;
constexpr int C_QN = 0, C_KC = 512, C_VC = 640, C_KS = 768, C_VS = 896, C_KW = 1024, C_VW = 1152, C_GT = 1280, C_QS = 1304, C_KSB = 1816, C_VSB = 2328;

constexpr size_t MiB = (size_t)1 << 20;
constexpr size_t WS_CTL = 0;
constexpr size_t WS_WGU1 = 1 * MiB, WS_WD1 = 12 * MiB, WS_WGU2 = 18 * MiB, WS_WD2 = 29 * MiB;
constexpr size_t WS_WIN = 35 * MiB, WS_WOUT = 41 * MiB, WS_WMQ = 43 * MiB, WS_WMKV = 43 * MiB + MiB / 2, WS_WMO = 44 * MiB + MiB / 2;
constexpr size_t WS_WC1K = 45 * MiB, WS_WC1V = 46 * MiB;
constexpr size_t WS_ROPEC = 47 * MiB, WS_ROPES = 48 * MiB;
constexpr size_t WS_GATES = 49 * MiB;
constexpr size_t WS_IDX = 52 * MiB;
constexpr size_t WS_SELM = 64 * MiB;
constexpr size_t WS_KC = 56 * MiB, WS_VC = 57 * MiB;
constexpr size_t WS_KCB = 52 * MiB, WS_VCB = 52 * MiB + MiB / 2;
constexpr size_t WS_HC = 58 * MiB;
constexpr size_t WS_KMEM = 62 * MiB, WS_VMEM = 62 * MiB + MiB / 2;
constexpr size_t WS_W2T = 63 * MiB + 960 * 1024;
constexpr size_t WS_BIASW = 63 * MiB + 896 * 1024;
constexpr size_t WS_BIASC = 63 * MiB;
constexpr size_t WS_GTAB = 63 * MiB + 4096;
constexpr size_t WS_GMAX = 63 * MiB + 4096 + 1024;
constexpr size_t WS_RMS1 = 63 * MiB + 768 * 1024;
constexpr size_t WS_BIASP = 63 * MiB + 512 * 1024;
constexpr size_t WS_ROWSQ = 63 * MiB + 65536;
constexpr size_t WS_XN = 65 * MiB;
constexpr size_t WS_ACT = 131 * MiB;
constexpr size_t WS_QN = 131 * MiB;
constexpr size_t WS_KS = 163 * MiB, WS_VS = 171 * MiB, WS_KW = 179 * MiB, WS_VW = 187 * MiB, WS_KCR = 195 * MiB, WS_VCR = 203 * MiB;
constexpr size_t WS_QS = 212 * MiB;
constexpr size_t WS_KSB = 244 * MiB, WS_VSB = 276 * MiB;
constexpr size_t WS_MIX = 308 * MiB;
constexpr size_t WS_QMEM = 372 * MiB, WS_OMEM = 388 * MiB;
constexpr size_t WS_OCB = 404 * MiB, WS_OSB = 436 * MiB;
constexpr size_t WS_NEED = 468 * MiB;

constexpr int CW_XRANK = 4096, CW_VCU = 8192, CW_SBQ = 12288;
struct Params {
    const float* in[32];
    const int* pos;
    float* out;
    unsigned char* ws;
};

#define GAS __attribute__((address_space(1)))
#define LAS __attribute__((address_space(3)))
typedef unsigned short bf16;
typedef unsigned v4u __attribute__((ext_vector_type(4)));
typedef unsigned v2u __attribute__((ext_vector_type(2)));
__device__ __forceinline__ int tid_() { int t = threadIdx.x; asm volatile("" : "+v"(t)); return t; }
template <int K> __device__ __forceinline__ float shx(float v) {
    if constexpr (K == 32) {
        const unsigned u = __builtin_bit_cast(unsigned, v); auto r = __builtin_amdgcn_permlane32_swap(u, u, false, false);
        return __builtin_bit_cast(float, (unsigned)((__builtin_amdgcn_mbcnt_hi(~0u, __builtin_amdgcn_mbcnt_lo(~0u, 0u)) >= 32u) ? r[0] : r[1]));
    } else if constexpr (K == 1) return __builtin_bit_cast(float, __builtin_amdgcn_mov_dpp(__builtin_bit_cast(int, v), 0xB1, 0xf, 0xf, true));
    else if constexpr (K == 2) return __builtin_bit_cast(float, __builtin_amdgcn_mov_dpp(__builtin_bit_cast(int, v), 0x4E, 0xf, 0xf, true));
    else return __builtin_bit_cast(float, __builtin_amdgcn_ds_swizzle(__builtin_bit_cast(int, v), (K << 10) | 0x1f));
}
template <int K> __device__ __forceinline__ int shxi(int v) { return __builtin_bit_cast(int, shx<K>(__builtin_bit_cast(float, v))); }
__device__ __forceinline__ float wave_sum(float v) { v += shx<1>(v); v += shx<2>(v); v += shx<4>(v); v += shx<8>(v); v += shx<16>(v); v += shx<32>(v); return v; }
__device__ __forceinline__ float wave_max(float v) { v = fmaxf(v, shx<1>(v)); v = fmaxf(v, shx<2>(v)); v = fmaxf(v, shx<4>(v)); v = fmaxf(v, shx<8>(v)); v = fmaxf(v, shx<16>(v)); v = fmaxf(v, shx<32>(v)); return v; }
#define LDS_FENCE() do { asm volatile("s_waitcnt lgkmcnt(0)" ::: "memory"); __builtin_amdgcn_wave_barrier(); } while (0)
__device__ __forceinline__ unsigned f2bf(float f) { unsigned u = __builtin_bit_cast(unsigned, f); return (u + 0x7fffu + ((u >> 16) & 1u)) >> 16; }
__device__ __forceinline__ unsigned pk2(float lo, float hi) { return f2bf(lo) | (f2bf(hi) << 16); }
__device__ __forceinline__ float bf2f(bf16 v) { return __builtin_bit_cast(float, (unsigned)v << 16); }

__device__ __forceinline__ void sincos_acc(float ang, float& s, float& c) {
    const double a = (double)ang;
    const double k = rint(a * 0.63661977236758134308);
    const double r = fma(-k, 1.57079632679489661923, a) - k * 6.123233995736766e-17;
    const double r2 = r * r;
    double sp = r * (1.0 + r2 * (-1.0 / 6 + r2 * (1.0 / 120 + r2 * (-1.0 / 5040 + r2 * (1.0 / 362880 + r2 * (-1.0 / 39916800 + r2 * (1.0 / 6227020800.0)))))));
    double cp = 1.0 + r2 * (-0.5 + r2 * (1.0 / 24 + r2 * (-1.0 / 720 + r2 * (1.0 / 40320 + r2 * (-1.0 / 3628800 + r2 * (1.0 / 479001600.0 + r2 * (-1.0 / 87178291200.0)))))));
    const int q = ((int)k) & 3;
    double ss = (q & 1) ? cp : sp, cc = (q & 1) ? sp : cp;
    if (q == 1) cc = -cc; else if (q == 2) { ss = -ss; cc = -cc; } else if (q == 3) ss = -ss;
    s = (float)ss; c = (float)cc;
}
__device__ __forceinline__ float gelu_tanh(float x) { return 0.5f * x * (1.0f + tanhf(0.7978845608028654f * (x + 0.044715f * x * x * x))); }
__device__ __forceinline__ float sigmoidf_(float x) { return 1.0f / (1.0f + expf(-x)); }
__device__ __forceinline__ float softplusf_(float z) { return fmaxf(z, 0.f) + log1pf(expf(-fabsf(z))); }
__constant__ float ROPE_FREQ[8] = {1.0f, 0.19392274f, 0.03760603f, 0.0072926646f, 0.0014142136f, 0.0002742482f, 5.3182957e-05f, 1.0313385e-05f};

__host__ __device__ __forceinline__ int colmap_rope(int wc, int d) {
    if (d < 16) { const int i = d & 7, half = d >> 3; return 32 * wc + 8 * (i >> 1) + 2 * half + (i & 1); }
    if (d < 32) return 32 * wc + 8 * ((d - 16) >> 2) + 4 + ((d - 16) & 3);
    return 128 + 32 * wc + (d - 32);
}
__host__ __device__ __forceinline__ int colmap_head(int wc, int d) { return d < 32 ? 32 * wc + d : 128 + 32 * wc + (d - 32); }
namespace pg8 {
#define PG8_LAS __attribute__((address_space(3)))
typedef unsigned short bf16_t;
typedef short bf16x8 __attribute__((ext_vector_type(8)));
typedef float f32x4 __attribute__((ext_vector_type(4)));
typedef unsigned u32x4 __attribute__((ext_vector_type(4)));
constexpr int BM = 256, BK = 64, HALF = 128, HTB = HALF * BK * 2  , STAGE_BYTES = 8 * HTB, NXCD = 8, WGM = 8;

__host__ __device__ __forceinline__ int lds_byte(int r, int c) { const int st = (r >> 4) * 2 + (c >> 5), rr = r & 15, cc = c & 31, ob = rr * 64 + cc * 2; return st * 1024 + (ob ^ (((ob >> 9) & 1) << 5)); }
__host__ __device__ __forceinline__ void stage_rc(int b, int& R, int& C) { const int st = b / 1024, sb = b % 1024, swz = sb ^ (((sb >> 9) & 1) << 5); R = (st >> 1) * 16 + swz / 64; C = (st & 1) * 32 + (swz % 64) / 2; }
__host__ __device__ __forceinline__ int perm32(int rho) { const int n = rho >> 4, i = rho & 15; return 8 * (i >> 2) + 4 * n + (i & 3); }

struct Unit { int pm, pn; };
struct Gemm { const bf16_t* A; const bf16_t* Bt; int M, N, K, lda; };

struct StaticOrder {
    int nM, nN, nwg, G, c;
    __host__ __device__ void init(int M, int N, int G_, int c_) { nM = M / BM; nN = N / BM; nwg = nM * nN; G = G_; c = c_; }
    __host__ __device__ bool next(int i, Unit& u) const {
        const long L = (long)i * G + c; if (L >= nwg) return false;
        int wgid = (int)L; { const int q = nwg / NXCD, r = nwg % NXCD, xcd = wgid % NXCD, off = wgid / NXCD; wgid = (xcd < r ? xcd * (q + 1) : r * (q + 1) + (xcd - r) * q) + off; }
        const int nig = WGM * nN, gid = wgid / nig, fm = gid * WGM, gsz = (nM - fm) < WGM ? (nM - fm) : WGM;
        u.pm = fm + ((wgid % nig) % gsz); u.pn = (wgid % nig) / gsz; return true;
    }
    __device__ __forceinline__ void a_ready(const Unit&) const {}
    __device__ __forceinline__ void done(const Unit&) const {}
};


__device__ __forceinline__ unsigned cvt_pk_bf16(float lo, float hi) { unsigned r; asm volatile("v_cvt_pk_bf16_f32 %0, %1, %2" : "=v"(r) : "v"(lo), "v"(hi)); return r; }
template <class Epi, class Sched, bool ALIGN_EPI = false, bool SP2 = false>
__device__ __forceinline__ void gemm_phase(PG8_LAS unsigned char* lds, const Gemm g, const Sched& S, const Epi& E) {
    const int tid = tid_(), wid = __builtin_amdgcn_readfirstlane(tid >> 6), lane = tid & 63, wr = wid >> 2, wc = wid & 3, fr = lane & 15, fq = lane >> 4;
    const int K = g.K, nt = K / BK;
    unsigned voffA[2], voffB[2];
#pragma unroll
    for (int i = 0; i < 2; ++i) { int R, C; stage_rc(tid * 16 + i * 8192, R, C); const int Rb = Epi::PERM ? ((R & ~31) + perm32(R & 31)) : R;
        voffA[i] = (unsigned)(R * g.lda + C) * 2u; voffB[i] = (unsigned)(Rb * K + C) * 2u; }
    const size_t kstep = (size_t)(BK * 2);
    const size_t hstep = (size_t)HALF * K * 2;
    const size_t tstep = 2 * hstep;
    const size_t hstepA = (size_t)HALF * g.lda * 2, tstepA = 2 * hstepA;
    const unsigned ldsw = (unsigned)wid * 1024u;
    const int aoff = lds_byte(wr * 64 + fr, fq * 8), boff = lds_byte(wc * 32 + fr, fq * 8);
#define PG8_SA(b, h) (((b) * 2 + (h)) * HTB)
#define PG8_SB(b, h) ((4 + (b) * 2 + (h)) * HTB)
#define PG8_STAGE(bufoff, gbase, voff) do { _Pragma("unroll") for (int _i = 0; _i < 2; ++_i) \
        __builtin_amdgcn_global_load_lds((const unsigned*)((const char*)(gbase) + (voff)[_i]), (PG8_LAS unsigned*)(lds + (bufoff) + ldsw + _i * 8192), 16, 0, 0); } while (0)
#define PG8_LDA(dst, b, h) do { _Pragma("unroll") for (int m = 0; m < 4; ++m) _Pragma("unroll") for (int k = 0; k < 2; ++k) dst[m][k] = *(const PG8_LAS bf16x8*)(lds + PG8_SA(b, h) + aoff + m * 2048 + k * 1024); } while (0)
#define PG8_LDB(dst, b, h) do { _Pragma("unroll") for (int n = 0; n < 2; ++n) _Pragma("unroll") for (int k = 0; k < 2; ++k) dst[n][k] = *(const PG8_LAS bf16x8*)(lds + PG8_SB(b, h) + boff + n * 2048 + k * 1024); } while (0)
#define PG8_MMA(ai, bj, At, Bt) do { __builtin_amdgcn_s_setprio(1); _Pragma("unroll") for (int m = 0; m < 4; ++m) _Pragma("unroll") for (int n = 0; n < 2; ++n) _Pragma("unroll") for (int k = 0; k < 2; ++k) \
        acc[ai][bj][m][n] = __builtin_amdgcn_mfma_f32_16x16x32_bf16(Bt[n][k], At[m][k], acc[ai][bj][m][n], 0, 0, 0); __builtin_amdgcn_s_setprio(0); } while (0)
#define PG8_WAIT_V(n) asm volatile("s_waitcnt vmcnt(" #n ")" ::: "memory")
#define PG8_WAIT_L(n) asm volatile("s_waitcnt lgkmcnt(" #n ")" ::: "memory")
#define PG8_BAR __builtin_amdgcn_s_barrier()
#define PG8_SCHED __builtin_amdgcn_sched_barrier(0)
    Unit cur, nxt; int ui = 0;
    if (!S.next(0, cur)) return;
    f32x4 acc[2][2][4][2];
#pragma unroll
    for (int a = 0; a < 2; ++a)
#pragma unroll
        for (int b = 0; b < 2; ++b)
#pragma unroll
            for (int m = 0; m < 4; ++m)
#pragma unroll
                for (int n = 0; n < 2; ++n) acc[a][b][m][n] = (f32x4){0.f, 0.f, 0.f, 0.f};
    bf16x8 At[4][2], B0[2][2], B1[2][2];
    const char* cA = (const char*)g.A + (size_t)cur.pm * tstepA; const char* cB = (const char*)g.Bt + (size_t)cur.pn * tstep;
    S.a_ready(cur);
    if constexpr (SP2) {
        PG8_STAGE(PG8_SB(0, 0), cB, voffB); PG8_STAGE(PG8_SB(0, 1), cB + hstep, voffB); PG8_STAGE(PG8_SA(0, 0), cA, voffA); PG8_STAGE(PG8_SA(0, 1), cA + hstepA, voffA);
        if (wr == 1) PG8_BAR;
        PG8_WAIT_V(2); PG8_BAR;
        PG8_STAGE(PG8_SB(1, 0), cB + kstep, voffB); PG8_STAGE(PG8_SA(1, 0), cA + kstep, voffA); PG8_STAGE(PG8_SB(1, 1), cB + hstep + kstep, voffB);
        PG8_WAIT_V(6); PG8_BAR;
    } else {
        PG8_STAGE(PG8_SB(0, 0), cB, voffB); PG8_STAGE(PG8_SA(0, 0), cA, voffA); PG8_STAGE(PG8_SB(0, 1), cB + hstep, voffB); PG8_STAGE(PG8_SA(0, 1), cA + hstepA, voffA);
        if (wr == 1) PG8_BAR;
        PG8_WAIT_V(4); PG8_BAR;
        PG8_STAGE(PG8_SB(1, 0), cB + kstep, voffB); PG8_STAGE(PG8_SA(1, 0), cA + kstep, voffA); PG8_STAGE(PG8_SB(1, 1), cB + hstep + kstep, voffB);
        PG8_WAIT_V(6); PG8_BAR;
    }
    for (;;) {
        const bool has_next = S.next(ui + 1, nxt);
        const char* nA = has_next ? (const char*)g.A + (size_t)nxt.pm * tstepA : cA; const char* nB = has_next ? (const char*)g.Bt + (size_t)nxt.pn * tstep : cB;
        for (int t = 0; t < nt; t += 2) {
            const bool last = (t == nt - 2);
            const char* a1 = cA + (size_t)(t + 1) * kstep;
            const char* a2 = last ? nA : cA + (size_t)(t + 2) * kstep; const char* b2 = last ? nB : cB + (size_t)(t + 2) * kstep;
            const char* a3 = a2 + kstep; const char* b3 = b2 + kstep;
            if (last && has_next) S.a_ready(nxt);
            if constexpr (SP2) {
            PG8_LDB(B0, 0, 0); PG8_LDB(B1, 0, 1); PG8_SCHED; PG8_LDA(At, 0, 0); PG8_STAGE(PG8_SA(1, 1), a1 + hstepA, voffA);
            PG8_WAIT_V(8); PG8_WAIT_L(0); PG8_BAR; PG8_MMA(0, 0, At, B0); PG8_MMA(0, 1, At, B1); PG8_BAR; PG8_SCHED;
            PG8_LDA(At, 0, 1); PG8_STAGE(PG8_SB(0, 0), b2, voffB); PG8_STAGE(PG8_SB(0, 1), b2 + hstep, voffB); PG8_STAGE(PG8_SA(0, 0), a2, voffA);
            PG8_WAIT_V(8); PG8_WAIT_L(0); PG8_BAR; PG8_MMA(1, 0, At, B0); PG8_MMA(1, 1, At, B1); PG8_BAR; PG8_SCHED;
            PG8_LDB(B0, 1, 0); PG8_LDB(B1, 1, 1); PG8_SCHED; PG8_LDA(At, 1, 0); PG8_STAGE(PG8_SA(0, 1), a2 + hstepA, voffA);
            PG8_WAIT_V(8); PG8_WAIT_L(0); PG8_BAR; PG8_MMA(0, 0, At, B0); PG8_MMA(0, 1, At, B1); PG8_BAR; PG8_SCHED;
            PG8_LDA(At, 1, 1); PG8_STAGE(PG8_SB(1, 0), b3, voffB); PG8_STAGE(PG8_SB(1, 1), b3 + hstep, voffB); PG8_STAGE(PG8_SA(1, 0), a3, voffA);
            PG8_WAIT_V(8); PG8_WAIT_L(0); PG8_BAR; PG8_MMA(1, 0, At, B0); PG8_MMA(1, 1, At, B1); PG8_BAR; PG8_SCHED;
            } else {
            PG8_LDB(B0, 0, 0); PG8_SCHED; PG8_LDA(At, 0, 0); PG8_STAGE(PG8_SA(1, 1), a1 + hstepA, voffA);
            PG8_WAIT_L(8); PG8_BAR; PG8_WAIT_L(0); PG8_MMA(0, 0, At, B0); PG8_BAR; PG8_SCHED;
            PG8_LDB(B1, 0, 1); PG8_STAGE(PG8_SB(0, 0), b2, voffB);
            PG8_BAR; PG8_WAIT_L(0); PG8_MMA(0, 1, At, B1); PG8_BAR;
            PG8_LDA(At, 0, 1); PG8_STAGE(PG8_SA(0, 0), a2, voffA);
            PG8_BAR; PG8_WAIT_L(0); PG8_MMA(1, 0, At, B0); PG8_BAR; PG8_SCHED;
            PG8_STAGE(PG8_SB(0, 1), b2 + hstep, voffB);
            PG8_WAIT_V(6); PG8_BAR; PG8_MMA(1, 1, At, B1); PG8_BAR;
            PG8_LDB(B0, 1, 0); PG8_SCHED; PG8_LDA(At, 1, 0); PG8_STAGE(PG8_SA(0, 1), a2 + hstepA, voffA);
            PG8_WAIT_L(8); PG8_BAR; PG8_WAIT_L(0); PG8_MMA(0, 0, At, B0); PG8_BAR; PG8_SCHED;
            PG8_LDB(B1, 1, 1); PG8_STAGE(PG8_SB(1, 0), b3, voffB);
            PG8_BAR; PG8_WAIT_L(0); PG8_MMA(0, 1, At, B1); PG8_BAR;
            PG8_LDA(At, 1, 1); PG8_STAGE(PG8_SA(1, 0), a3, voffA);
            PG8_BAR; PG8_WAIT_L(0); PG8_MMA(1, 0, At, B0); PG8_BAR; PG8_SCHED;
            PG8_STAGE(PG8_SB(1, 1), b3 + hstep, voffB);
            PG8_WAIT_V(6); PG8_BAR; PG8_MMA(1, 1, At, B1); PG8_BAR;
            }
        }
        if constexpr (ALIGN_EPI) { if (wr == 0) PG8_BAR; }
        if constexpr (!Epi::AFTER_DRAIN) { E(acc, cur, wr, wc, fr, fq); S.done(cur); }
        if (!has_next) break;
#pragma unroll
        for (int a = 0; a < 2; ++a)
#pragma unroll
            for (int b = 0; b < 2; ++b)
#pragma unroll
                for (int m = 0; m < 4; ++m)
#pragma unroll
                    for (int n = 0; n < 2; ++n) acc[a][b][m][n] = (f32x4){0.f, 0.f, 0.f, 0.f};
        cur = nxt; cA = nA; cB = nB; ++ui;
        if constexpr (ALIGN_EPI) { if (wr == 1) PG8_BAR; }
    }
    PG8_WAIT_V(0);
    if constexpr (!ALIGN_EPI) { if (wr == 0) PG8_BAR; }
    PG8_BAR;
    if constexpr (Epi::AFTER_DRAIN) { E.fused(acc, cur, wr, wc, fr, fq, lds, wid, lane); S.done(cur); }
#undef PG8_SA
#undef PG8_SB
#undef PG8_STAGE
#undef PG8_LDA
#undef PG8_LDB
#undef PG8_MMA
#undef PG8_WAIT_V
#undef PG8_WAIT_L
#undef PG8_BAR
#undef PG8_SCHED
}

__device__ __forceinline__ v4u pack8(const f32x4& a, const f32x4& b) { v4u w; w.x = cvt_pk_bf16(a[0], a[1]); w.y = cvt_pk_bf16(a[2], a[3]); w.z = cvt_pk_bf16(b[0], b[1]); w.w = cvt_pk_bf16(b[2], b[3]); return w; }
__device__ __forceinline__ float dot4(const f32x4& a) { return (a[0] * a[0] + a[1] * a[1]) + (a[2] * a[2] + a[3] * a[3]); }
struct EpiSwiglu {
    static constexpr bool PERM = true, AFTER_DRAIN = false;
    bf16_t* O; int ldo; const float* rowsq;
    __device__ __forceinline__ void operator()(const f32x4 (&acc)[2][2][4][2], const Unit& u, int wr, int wc, int fr, int fq) const {
        const int row0 = u.pm * BM + wr * 64 + fr, col0 = u.pn * HALF + wc * 32 + 8 * fq;
#pragma unroll
        for (int ai = 0; ai < 2; ++ai)
#pragma unroll
            for (int m = 0; m < 4; ++m) {
                bf16_t* rowp = O + (size_t)(row0 + ai * HALF + m * 16) * ldo + col0;
                const float ms = rowsq ? rowsq[row0 + ai * HALF + m * 16] * (1.0f / 1024.0f) + EPS : 1.0f, c1 = -1.4426950408889634f * (rowsq ? rsqrtf(ms) : 1.0f);
                f32x4 o[2]; typedef float f32x2 __attribute__((ext_vector_type(2)));
#pragma unroll
                for (int n = 0; n < 2; ++n)
#pragma unroll
                    for (int j = 0; j < 4; j += 2) { const f32x2 g = {acc[ai][0][m][n][j], acc[ai][0][m][n][j + 1]}, up = {acc[ai][1][m][n][j], acc[ai][1][m][n][j + 1]};
                        f32x2 e = g * c1; e = (f32x2){__builtin_amdgcn_exp2f(e[0]), __builtin_amdgcn_exp2f(e[1])};
                        f32x2 d = __builtin_elementwise_fma(e, (f32x2){ms, ms}, (f32x2){ms, ms}); d = (f32x2){__builtin_amdgcn_rcpf(d[0]), __builtin_amdgcn_rcpf(d[1])};
                        const f32x2 r = (g * up) * d; o[n][j] = r[0]; o[n][j + 1] = r[1]; }
                *(v4u*)rowp = pack8(o[0], o[1]);
            }
    }
};
template <bool NORM, int rs, bool HALFSTEP, bool BASEBF, bool OUTF32> struct EpiResid {
    static constexpr bool PERM = false, AFTER_DRAIN = false; static constexpr int ldc = D_; static constexpr float alpha = HALFSTEP ? 0.5f : 1.0f;
    const float* base; float* out; unsigned char* ws; const float* g1;
    __device__ __forceinline__ void operator()(const f32x4 (&acc)[2][2][4][2], const Unit& u, int wr, int wc, int fr, int fq) const {
        bf16_t* xb = (bf16_t*)(ws + WS_XN);
        f32x4 gi[2][2]; bool usexn = false;
        if (g1) {
            float gmin = 1e30f;
#pragma unroll
            for (int bj = 0; bj < 2; ++bj)
#pragma unroll
                for (int n = 0; n < 2; ++n) { const f32x4 gg = *(const f32x4*)(g1 + u.pn * BM + wc * 32 + 4 * fq + bj * HALF + n * 16);
                    gmin = fminf(gmin, fminf(fminf(fabsf(gg[0]), fabsf(gg[1])), fminf(fabsf(gg[2]), fabsf(gg[3]))));
                    gi[bj][n] = (f32x4){__builtin_amdgcn_rcpf(gg[0]), __builtin_amdgcn_rcpf(gg[1]), __builtin_amdgcn_rcpf(gg[2]), __builtin_amdgcn_rcpf(gg[3])}; }
            usexn = __all(gmin > 0.25f);
        }
#pragma unroll
        for (int ai = 0; ai < 2; ++ai)
#pragma unroll
            for (int m = 0; m < 4; ++m) {
                const int row = u.pm * BM + ai * HALF + wr * 64 + m * 16 + fr;
                const size_t ro = (size_t)row * ldc + u.pn * BM + wc * 32 + 4 * fq;
                float ss = 0.f; const float rms1 = (!BASEBF && usexn) ? ((const float*)(ws + WS_RMS1))[row] : 1.0f;
#pragma unroll
                for (int bj = 0; bj < 2; ++bj)
#pragma unroll
                    for (int n = 0; n < 2; ++n) { const size_t o = ro + bj * HALF + n * 16;
                        f32x4 bs;
                        if (BASEBF || usexn) { const v2u q = *(const v2u*)(xb + o);
                            bs = (f32x4){__builtin_bit_cast(float, q.x << 16), __builtin_bit_cast(float, q.x & 0xffff0000u), __builtin_bit_cast(float, q.y << 16), __builtin_bit_cast(float, q.y & 0xffff0000u)};
                            if (!BASEBF) bs = bs * gi[bj][n] * rms1; }
                        else bs = *(const f32x4*)(base + o);
                        const f32x4 v = bs + acc[ai][bj][m][n] * alpha;
                        if constexpr (OUTF32) *(f32x4*)(out + o) = v;
                        if constexpr (NORM) { v2u q; q.x = cvt_pk_bf16(v[0], v[1]); q.y = cvt_pk_bf16(v[2], v[3]); *(v2u*)(xb + o) = q; ss += dot4(v); } }
                if constexpr (NORM) { ss += shx<16>(ss); ss += shx<32>(ss); if (fq == 0) atomicAdd((float*)(ws + WS_ROWSQ) + (size_t)rs * NT + row, ss); }
                asm volatile("" ::: "memory");
            }
    }
};
struct EpiWin {
    static constexpr bool PERM = true, AFTER_DRAIN = false;
    unsigned char* ws; const float* rowsq;
    __device__ __forceinline__ void operator()(const f32x4 (&acc)[2][2][4][2], const Unit& u, int wr, int wc, int fr, int fq) const {
        const int tile = u.pn, rowb = u.pm * BM + wr * 64 + fr;
        if (tile <= 2) {
            const float* g = (const float*)(ws + WS_GTAB) + (tile < 2 ? 0 : (wc < 2 ? 64 : 128));
            const float ga0 = g[2 * fq], ga1 = g[2 * fq + 1], ga2 = g[8 + 2 * fq], ga3 = g[9 + 2 * fq];
            const f32x4 gb = *(const f32x4*)(g + 16 + 4 * fq), gc0 = *(const f32x4*)(g + 32 + 8 * fq), gc1 = *(const f32x4*)(g + 36 + 8 * fq);
            const float* ropec = (const float*)(ws + WS_ROPEC); const float* ropes = (const float*)(ws + WS_ROPES);
#pragma unroll
            for (int ai = 0; ai < 2; ++ai)
#pragma unroll
                for (int m = 0; m < 4; ++m) {
                    const int row = rowb + ai * HALF + m * 16, b = row >> 13, t = row & (T_ - 1);
                    const float rr = rsqrtf(rowsq[row] * (1.0f / 1024.0f) + EPS);
                    const f32x4 v0 = acc[ai][0][m][0] * rr, v1 = acc[ai][0][m][1] * rr, w0 = acc[ai][1][m][0] * rr, w1 = acc[ai][1][m][1] * rr;
                    float ss = (dot4(v0) + dot4(v1)) + (dot4(w0) + dot4(w1));
                    ss += shx<16>(ss); ss += shx<32>(ss);
                    const float r = rsqrtf(ss * (1.0f / 64.0f) + EPS) * (tile < 2 ? Q_SCALE : 1.0f);
                    const float y0 = v0[0] * r * ga0, y1 = v0[1] * r * ga1, y2 = v0[2] * r * ga2, y3 = v0[3] * r * ga3;
                    const float2 cc = *(const float2*)(ropec + (size_t)row * 8 + 2 * fq), sn = *(const float2*)(ropes + (size_t)row * 8 + 2 * fq);
                    const float o0 = y0 * cc.x - y2 * sn.x, o2 = y2 * cc.x + y0 * sn.x, o1 = y1 * cc.y - y3 * sn.y, o3 = y3 * cc.y + y1 * sn.y;
                    bf16_t* dst = tile < 2 ? (bf16_t*)(ws + WS_QN) + (size_t)row * 512 + (tile * 4 + wc) * 64
                                           : (bf16_t*)(ws + (wc < 2 ? WS_KS : WS_KW)) + ((size_t)(b * 2 + (wc & 1)) * T_ + t) * 64;
                    *(unsigned*)(dst + 2 * fq) = cvt_pk_bf16(o0, o1);
                    *(unsigned*)(dst + 8 + 2 * fq) = cvt_pk_bf16(o2, o3);
                    v2u q; q.x = cvt_pk_bf16(v1[0] * r * gb[0], v1[1] * r * gb[1]); q.y = cvt_pk_bf16(v1[2] * r * gb[2], v1[3] * r * gb[3]);
                    *(v2u*)(dst + 16 + 4 * fq) = q;
                    *(v4u*)(dst + 32 + 8 * fq) = pack8(w0 * r * gc0, w1 * r * gc1);
                }
        } else if (tile == 5) {
            if (wc == 0 && fq < 3) {
                float* G = (float*)(ws + WS_GATES);
#pragma unroll
                for (int ai = 0; ai < 2; ++ai)
#pragma unroll
                    for (int m = 0; m < 4; ++m) {
                        const int row = rowb + ai * HALF + m * 16; const float rr = rsqrtf(rowsq[row] * (1.0f / 1024.0f) + EPS);
#pragma unroll
                        for (int n = 0; n < 2; ++n) { f32x4 o;
#pragma unroll
                            for (int j = 0; j < 4; ++j) o[j] = __builtin_amdgcn_rcpf(1.0f + __builtin_amdgcn_exp2f(-1.4426950408889634f * rr * acc[ai][0][m][n][j]));
                            *(f32x4*)(G + (size_t)row * 24 + 8 * fq + 4 * n) = o; }
                    }
            }
        } else {
            const int c0 = 32 * wc + 8 * fq;
#pragma unroll
            for (int ai = 0; ai < 2; ++ai)
#pragma unroll
                for (int m = 0; m < 4; ++m) {
                    const int row = rowb + ai * HALF + m * 16, b = row >> 13, t = row & (T_ - 1);
                    bf16_t *d0, *d1;
                    if (tile == 3 || tile == 4) {
                        const size_t o = ((size_t)(b * 2 + (wc >> 1)) * T_ + t) * 64 + (c0 & 63);
                        d0 = (bf16_t*)(ws + (tile == 3 ? WS_KCR : WS_VS)) + o; d1 = (bf16_t*)(ws + (tile == 3 ? WS_VCR : WS_VW)) + o;
                    } else if (tile < 8) {
                        d0 = (bf16_t*)(ws + WS_QS) + (size_t)row * 512 + (tile - 6) * 256 + c0; d1 = d0 + 128;
                    } else {
                        const int tb = tile < 10 ? tile - 8 : tile - 10;
                        const int col0 = tb * 256 + c0, col1 = col0 + 128;
                        bf16_t* base = (bf16_t*)(ws + (tile < 10 ? WS_KSB : WS_VSB));
                        d0 = base + ((size_t)(b * 8 + (col0 >> 6)) * T_ + t) * 64 + (col0 & 63);
                        d1 = base + ((size_t)(b * 8 + (col1 >> 6)) * T_ + t) * 64 + (col1 & 63);
                    }
                    const float sc = ((tile == 6 || tile == 7) ? Q_SCALE : 1.0f) * rsqrtf(rowsq[row] * (1.0f / 1024.0f) + EPS);
                    *(v4u*)d0 = pack8(acc[ai][0][m][0] * sc, acc[ai][0][m][1] * sc);
                    *(v4u*)d1 = pack8(acc[ai][1][m][0] * sc, acc[ai][1][m][1] * sc);
                }
        }
    }
};
struct EpiHeadNorm {
    static constexpr bool PERM = true, AFTER_DRAIN = false;
    bf16_t* O0; bf16_t* O1; const float* g; float scale; const float* rowsq;
    __device__ __forceinline__ void operator()(const f32x4 (&acc)[2][2][4][2], const Unit& u, int wr, int wc, int fr, int fq) const {
        const int rowb = u.pm * BM + wr * 64 + fr;
        const f32x4 g0 = *(const f32x4*)(g + 8 * fq), g1 = *(const f32x4*)(g + 8 * fq + 4), g2 = *(const f32x4*)(g + 32 + 8 * fq), g3 = *(const f32x4*)(g + 36 + 8 * fq);
#pragma unroll
        for (int ai = 0; ai < 2; ++ai)
#pragma unroll
            for (int m = 0; m < 4; ++m) {
                const int row = rowb + ai * HALF + m * 16; const float rr = rowsq ? rsqrtf(rowsq[row] * (1.0f / 1024.0f) + EPS) : 1.0f;
                const f32x4 v0 = acc[ai][0][m][0] * rr, v1 = acc[ai][0][m][1] * rr, w0 = acc[ai][1][m][0] * rr, w1 = acc[ai][1][m][1] * rr;
                if (u.pn == 0) {
                    float ss = (dot4(v0) + dot4(v1)) + (dot4(w0) + dot4(w1));
                    ss += shx<16>(ss); ss += shx<32>(ss);
                    const float r = rsqrtf(ss * (1.0f / 64.0f) + EPS) * scale;
                    bf16_t* dst = O0 + (size_t)row * 256 + wc * 64;
                    *(v4u*)(dst + 8 * fq) = pack8(v0 * r * g0, v1 * r * g1);
                    *(v4u*)(dst + 32 + 8 * fq) = pack8(w0 * r * g2, w1 * r * g3);
                } else {
                    bf16_t* dst = O1 + (size_t)row * 256 + 32 * wc + 8 * fq;
                    *(v4u*)dst = pack8(v0, v1);
                    *(v4u*)(dst + 128) = pack8(w0, w1);
                }
            }
    }
};
struct EpiCmp1 {
    static constexpr bool PERM = true, AFTER_DRAIN = false;
    bf16_t* O; const float* bias;
    __device__ __forceinline__ void operator()(const f32x4 (&acc)[2][2][4][2], const Unit& u, int wr, int wc, int fr, int fq) const {
        const int rowb = u.pm * BM + wr * 64 + fr, c0 = 32 * wc + 8 * fq;
#pragma unroll
        for (int bj = 0; bj < 2; ++bj) {
            const f32x4 b0 = *(const f32x4*)(bias + bj * HALF + c0), b1 = *(const f32x4*)(bias + bj * HALF + c0 + 4);
#pragma unroll
            for (int ai = 0; ai < 2; ++ai)
#pragma unroll
                for (int m = 0; m < 4; ++m) {
                    f32x4 x0 = acc[ai][bj][m][0] + b0, x1 = acc[ai][bj][m][1] + b1;
#pragma unroll
                    for (int j = 0; j < 4; ++j) { x0[j] = gelu_tanh(x0[j]); x1[j] = gelu_tanh(x1[j]); }
                    *(v4u*)(O + (size_t)(rowb + ai * HALF + m * 16) * 256 + bj * HALF + c0) = pack8(x0, x1);
                }
        }
    }
};
struct OffsetOrder {
    int c, base, nM, nN;
    __device__ __forceinline__ bool next(int i, Unit& u) const { if (i != 0) return false; const int k = c - base; if (k < 0 || k >= nM * nN) return false; u.pm = k / nN; u.pn = k % nN; return true; }
    __device__ __forceinline__ void a_ready(const Unit&) const {}
    __device__ __forceinline__ void done(const Unit&) const {}
};
}


#define XB_TMO      128
#define XB_XCNT(j)  (256  + 64 * (j))
#define XB_XSUB(j)  (1280 + 64 * (j))
#define XB_XGEN(j)  (2304 + 64 * (j))
#define XB_TOP      3328
#define XB_TOPGEN   3392
#define XCD_BAR_WORDS 3456
#define XB_SPIN_CAP (1u << 18)

__device__ __forceinline__ unsigned xb_ld(unsigned* p)              { return __hip_atomic_load(p, __ATOMIC_RELAXED, __HIP_MEMORY_SCOPE_AGENT); }
__device__ __forceinline__ unsigned xb_add(unsigned* p, unsigned v) { return __hip_atomic_fetch_add(p, v, __ATOMIC_RELAXED, __HIP_MEMORY_SCOPE_AGENT); }
__device__ __forceinline__ unsigned xb_xcc_id() { return (unsigned)__builtin_amdgcn_s_getreg((3 << 11) | 20) & 0xFu; }
#define XB_SPIN(cond, bar) do { unsigned _sp = 0; while (cond) { __builtin_amdgcn_s_sleep(1); \
    if ((++_sp & 255u) == 0u) { if (xb_ld(&(bar)[XB_TMO])) break; if (_sp > XB_SPIN_CAP) { atomicAdd(&(bar)[XB_TMO], 1u); break; } } } } while (0)

struct XcdBarrier {
    unsigned* bar; unsigned x;
    volatile LAS unsigned* st;
};

__device__ __forceinline__ XcdBarrier xcd_barrier_post(unsigned* bar, volatile LAS unsigned* st) {
    XcdBarrier b; b.bar = bar; b.x = xb_xcc_id(); b.st = st;
    if (tid_() == 0) (void)xb_add(&bar[XB_XCNT(b.x)], 1u);
    return b;
}
__device__ __forceinline__ void xcd_barrier_complete(unsigned* bar, unsigned x, unsigned& nloc, unsigned& nx) {
    const unsigned G = gridDim.x * gridDim.y * gridDim.z;
    unsigned sum, cnt, mine, sp = 0u;
    for (;;) {
        sum = 0u; cnt = 0u; mine = 0u;
#pragma unroll
        for (unsigned j = 0; j < 16; ++j) { const unsigned c = xb_ld(&bar[XB_XCNT(j)]); sum += c; cnt += (c > 0u) ? 1u : 0u; mine = (j == x) ? c : mine; }
        if (sum == G) break;
        __builtin_amdgcn_s_sleep(1);
        if ((++sp & 255u) == 0u) { if (xb_ld(&bar[XB_TMO])) break; if (sp > XB_SPIN_CAP) { atomicAdd(&bar[XB_TMO], 1u); break; } }
    }
    nloc = mine > 0u ? mine : 1u; nx = cnt > 0u ? cnt : 1u;
}

__device__ __forceinline__ void xcd_barrier(const XcdBarrier& b) {
    asm volatile("s_waitcnt vmcnt(0)" ::: "memory");
    __syncthreads();
    if (tid_() == 0) {
        unsigned* bar = b.bar;
        __builtin_amdgcn_s_waitcnt(0);
        unsigned nloc = b.st[0], nx = b.st[1];
        if (nloc == 0u) { xcd_barrier_complete(bar, b.x, nloc, nx); b.st[0] = nloc; b.st[1] = nx; }
        const unsigned old = xb_add(&bar[XB_XSUB(b.x)], 1u);
        const unsigned gen = old / nloc;
        if (old + 1u == (gen + 1u) * nloc) {
            __builtin_amdgcn_fence(__ATOMIC_RELEASE, "agent");
            asm volatile("s_waitcnt vmcnt(0)" ::: "memory");
            const unsigned og = xb_add(&bar[XB_TOP], 1u);
            const unsigned tg = og / nx;
            if (og + 1u == (tg + 1u) * nx) xb_add(&bar[XB_TOPGEN], 1u);
            else XB_SPIN(xb_ld(&bar[XB_TOPGEN]) == tg, bar);
            __builtin_amdgcn_fence(__ATOMIC_ACQUIRE, "agent");
            xb_add(&bar[XB_XGEN(b.x)], 1u);
            asm volatile("s_waitcnt vmcnt(0)" ::: "memory");
        } else {
            if (old == gen * nloc) {
                __builtin_amdgcn_fence(__ATOMIC_RELEASE, "agent");
                asm volatile("s_waitcnt vmcnt(0)" ::: "memory"); }
            __builtin_amdgcn_fence(__ATOMIC_ACQUIRE, "agent");
            XB_SPIN(xb_ld(&bar[XB_XGEN(b.x)]) == gen, bar);
            asm volatile("s_waitcnt vmcnt(0)" ::: "memory");
        }
    }
    __syncthreads();
}


template <class RowMap>
__device__ __forceinline__ void transpose_item(const float* W, int K, int N, bf16* WT, LAS float* scr, int item2, int lane, const RowMap& rowmap, const float* gk = nullptr) {
    const int nblk = (N + 31) / 32; const int c4 = lane & 7, c = lane & 7;
    typedef float f4v __attribute__((ext_vector_type(4)));
    f4v v[2][8];
#pragma unroll
    for (int q = 0; q < 2; ++q) { const int item = 2 * item2 + q, kb = item / nblk, nb = item % nblk, k0 = 64 * kb, n0 = 32 * nb; const bool okn = n0 + 4 * c4 < N;
#pragma unroll
        for (int i = 0; i < 8; ++i) { const int kk = 8 * i + (lane >> 3);
            v[q][i] = (f4v){0.f, 0.f, 0.f, 0.f};
            if (okn) v[q][i] = __builtin_nontemporal_load((const f4v*)(W + (size_t)(k0 + kk) * N + n0 + 4 * c4)); } }
#pragma unroll
    for (int q = 0; q < 2; ++q) { const int item = 2 * item2 + q, kb = item / nblk, k0 = 64 * kb; LAS float* sc = scr + q * (64 * 33);
#pragma unroll
        for (int i = 0; i < 8; ++i) { const int kk = 8 * i + (lane >> 3); f4v t = v[q][i];
            if (gk) t = t * gk[k0 + kk];
            LAS float* d = sc + kk * 33 + 4 * c4; d[0] = t[0]; d[1] = t[1]; d[2] = t[2]; d[3] = t[3]; } }
    asm volatile("s_waitcnt lgkmcnt(0)" ::: "memory");
#pragma unroll
    for (int q = 0; q < 2; ++q) { const int item = 2 * item2 + q, kb = item / nblk, nb = item % nblk, k0 = 64 * kb, n0 = 32 * nb; const LAS float* sc = scr + q * (64 * 33);
#pragma unroll
        for (int j = 0; j < 4; ++j) { const int n = (lane >> 3) + 8 * j; const LAS float* sp = sc + (8 * c) * 33 + n;
            v4u o; o.x = pk2(sp[0 * 33], sp[1 * 33]); o.y = pk2(sp[2 * 33], sp[3 * 33]); o.z = pk2(sp[4 * 33], sp[5 * 33]); o.w = pk2(sp[6 * 33], sp[7 * 33]);
            if (n0 + n < N) *(v4u*)(WT + (size_t)rowmap(n0 + n) * K + k0 + 8 * c) = o; } }
    asm volatile("s_waitcnt lgkmcnt(0)" ::: "memory");
}
struct RmGate { __device__ int operator()(int n) const { return (n >> 7) * 256 + (n & 127); } };
struct RmUp { __device__ int operator()(int n) const { return (n >> 7) * 256 + 128 + (n & 127); } };
struct RmOff { int off; __device__ int operator()(int n) const { return n + off; } };
struct RmMemHead { __device__ int operator()(int n) const { return colmap_head(n >> 6, n & 63); } };
struct RmWin { __device__ int operator()(int n) const {
    if (n < C_KC) { const int h = n >> 6, d = n & 63; return (h >> 2) * 256 + colmap_rope(h & 3, d); }
    if (n < C_VC) return 3 * 256 + (n - C_KC);
    if (n < C_KS) return 3 * 256 + 128 + (n - C_VC);
    if (n < C_VS) { const int k = n - C_KS; return 2 * 256 + colmap_rope(k >> 6, k & 63); }
    if (n < C_KW) return 4 * 256 + (n - C_VS);
    if (n < C_VW) { const int k = n - C_KW; return 2 * 256 + colmap_rope(2 + (k >> 6), k & 63); }
    if (n < C_GT) return 4 * 256 + 128 + (n - C_VW);
    if (n < C_QS) return 5 * 256 + (n - C_GT);
    if (n < C_KSB) return 6 * 256 + (n - C_QS);
    if (n < C_VSB) return 8 * 256 + (n - C_KSB);
    return 10 * 256 + (n - C_VSB);
} };
__device__ __forceinline__ void ph_rmsnorm_bf16(const float* X, const float* g, bf16* O, int rows, float* rms_out = nullptr) {
    const int lane = tid_() & 63, wv = tid_() >> 6; const int S = gridDim.x * NWV;
    typedef float f4v __attribute__((ext_vector_type(4)));
    for (int r0 = blockIdx.x * NWV + wv; r0 < rows; r0 += 4 * S) {
        f4v v[4][4];
#pragma unroll
        for (int q = 0; q < 4; ++q) { const int r = r0 + q * S;
            if (r < rows) {
#pragma unroll
                for (int j = 0; j < 4; ++j) v[q][j] = __builtin_nontemporal_load((const f4v*)(X + (size_t)r * D_) + lane + 64 * j); } }
#pragma unroll
        for (int q = 0; q < 4; ++q) { const int r = r0 + q * S;
            if (r < rows) {
                float ss = 0.f;
#pragma unroll
                for (int j = 0; j < 4; ++j) ss += v[q][j][0] * v[q][j][0] + v[q][j][1] * v[q][j][1] + v[q][j][2] * v[q][j][2] + v[q][j][3] * v[q][j][3];
                const float ms = wave_sum(ss) * (1.f / D_) + EPS, rs = rsqrtf(ms);
                if (rms_out && lane == 0) rms_out[r] = sqrtf(ms);
                unsigned long long* o8 = (unsigned long long*)(O + (size_t)r * D_);
#pragma unroll
                for (int j = 0; j < 4; ++j) { const float4 gg = ((const float4*)g)[lane + 64 * j];
                    o8[lane + 64 * j] = (unsigned long long)pk2(v[q][j][0] * rs * gg.x, v[q][j][1] * rs * gg.y) | ((unsigned long long)pk2(v[q][j][2] * rs * gg.z, v[q][j][3] * rs * gg.w) << 32); } } }
    }
}
__device__ __forceinline__ void ph_prologue(const Params& p, LAS unsigned char* lds) {
    const int lane = tid_() & 63, wv = tid_() >> 6;
    LAS float* scr = (LAS float*)(lds + wv * 17408);
    constexpr int I_G = (D_ / 64) * (FF / 32) / 2, I_D = (FF / 64) * (D_ / 32) / 2, I_IN = (D_ / 64) * ((INC + 31) / 32) / 2, I_OUT = (D_ / 64) * (D_ / 32) / 2, I_M = (D_ / 64) * (256 / 32) / 2, I_MO = (256 / 64) * (D_ / 32) / 2, I_C1 = (2048 / 64) * (256 / 32) / 2;
    static_assert(((D_ / 64) * ((INC + 31) / 32)) % 2 == 0 && ((FF / 32) % 2) == 0, "items go in pairs");
    constexpr int NITEMS = 4 * I_G + 2 * I_D + I_IN + I_OUT + 3 * I_M + I_MO + 2 * I_C1;
    unsigned char* ws = p.ws;
    for (int it = blockIdx.x * NWV + wv; it < NITEMS; it += gridDim.x * NWV) {
        int r = it;
        if (r < I_G) { transpose_item(p.in[4], D_, FF, (bf16*)(ws + WS_WGU1), scr, r, lane, RmGate()); continue; } r -= I_G;
        if (r < I_G) { transpose_item(p.in[5], D_, FF, (bf16*)(ws + WS_WGU1), scr, r, lane, RmUp()); continue; } r -= I_G;
        if (r < I_D) { transpose_item(p.in[6], FF, D_, (bf16*)(ws + WS_WD1), scr, r, lane, RmOff{0}); continue; } r -= I_D;
        if (r < I_G) { transpose_item(p.in[29], D_, FF, (bf16*)(ws + WS_WGU2), scr, r, lane, RmGate(), p.in[28]); continue; } r -= I_G;
        if (r < I_G) { transpose_item(p.in[30], D_, FF, (bf16*)(ws + WS_WGU2), scr, r, lane, RmUp(), p.in[28]); continue; } r -= I_G;
        if (r < I_D) { transpose_item(p.in[31], FF, D_, (bf16*)(ws + WS_WD2), scr, r, lane, RmOff{0}); continue; } r -= I_D;
        if (r < I_IN) { transpose_item(p.in[8], D_, INC, (bf16*)(ws + WS_WIN), scr, r, lane, RmWin(), p.in[7]); continue; } r -= I_IN;
        if (r < I_OUT) { transpose_item(p.in[19], D_, D_, (bf16*)(ws + WS_WOUT), scr, r, lane, RmOff{0}); continue; } r -= I_OUT;
        if (r < I_M) { transpose_item(p.in[22], D_, 256, (bf16*)(ws + WS_WMQ), scr, r, lane, RmMemHead(), p.in[20]); continue; } r -= I_M;
        if (r < I_M) { transpose_item(p.in[23], D_, 256, (bf16*)(ws + WS_WMKV), scr, r, lane, RmMemHead()); continue; } r -= I_M;
        if (r < I_M) { transpose_item(p.in[24], D_, 256, (bf16*)(ws + WS_WMKV), scr, r, lane, RmOff{256}); continue; } r -= I_M;
        if (r < I_MO) { transpose_item(p.in[27], 256, D_, (bf16*)(ws + WS_WMO), scr, r, lane, RmOff{0}); continue; } r -= I_MO;
        if (r < I_C1) { transpose_item(p.in[14], 2048, 256, (bf16*)(ws + WS_WC1K), scr, r, lane, RmOff{0}); continue; } r -= I_C1;
        transpose_item(p.in[17], 2048, 256, (bf16*)(ws + WS_WC1V), scr, r, lane, RmOff{0});
    }
    float* rc = (float*)(ws + WS_ROPEC); float* rs = (float*)(ws + WS_ROPES);
    for (int i = blockIdx.x * NTHR + tid_(); i < NT * 8; i += gridDim.x * NTHR) {
        const float ang = (float)p.pos[i >> 3] * ROPE_FREQ[i & 7];
        float s, c; sincos_acc(ang, s, c); rc[i] = c; rs[i] = s;
    }
    for (int i = blockIdx.x * NTHR + tid_(); i < 3 * NT; i += gridDim.x * NTHR) ((float*)(ws + WS_ROWSQ))[i] = 0.f;
    if (blockIdx.x < 64) {
        const int i = tid_(), kv = i >> 8, j = i & 255; const float* pe = kv ? p.in[16] : p.in[13]; const float* w1 = kv ? p.in[17] : p.in[14];
        float a = 0.f;
#pragma unroll 8
        for (int k = 32 * blockIdx.x; k < 32 * blockIdx.x + 32; ++k) a = fmaf(pe[k], w1[(size_t)k * 256 + j], a);
        ((float*)(ws + WS_BIASP))[blockIdx.x * 512 + i] = a;
    }
    for (int i = blockIdx.x * NTHR + tid_(); i < 2 * 64 * 256; i += gridDim.x * NTHR) { const int kv = i >> 14, n = (i >> 8) & 63, k = i & 255; ((bf16*)(ws + WS_W2T))[i] = (bf16)f2bf((kv ? p.in[18] : p.in[15])[k * 64 + n]); }
    if (blockIdx.x == 1 && tid_() < 64) {
        const int l_ = tid_(); float* gm = (float*)(ws + WS_GMAX);
        const float m0 = wave_max(fabsf(p.in[9][l_])), m1 = wave_max(fabsf(p.in[10][l_])), m2 = wave_max(fabsf(p.in[11][l_])), m3 = wave_max(fabsf(p.in[12][l_])), m4 = wave_max(fabsf(p.in[25][l_])), m5 = wave_max(fabsf(p.in[26][l_]));
        if (l_ == 0) { gm[0] = m0; gm[1] = m1; gm[2] = m2; gm[3] = m3; gm[4] = m4; gm[5] = m5; } }
    if (blockIdx.x == 0 && tid_() < 64) { float* gt = (float*)(ws + WS_GTAB); gt[tid_()] = p.in[9][tid_()]; gt[64 + tid_()] = p.in[11][tid_()]; gt[128 + tid_()] = p.in[12][tid_()]; }
    ph_rmsnorm_bf16(p.in[1], p.in[21], (bf16*)(ws + WS_XN) + (size_t)NT * D_, NMEM);
    ph_rmsnorm_bf16(p.in[0], p.in[3], (bf16*)(ws + WS_XN), NT, (float*)(ws + WS_RMS1));
}

__device__ __forceinline__ void ph_bias_finish(const Params& p) {
    if (blockIdx.x == 0) { const int i = tid_(); const float* part = (const float*)(p.ws + WS_BIASP); float a = 0.f;
#pragma unroll 8
        for (int b = 0; b < 64; ++b) a += part[b * 512 + i];
        ((float*)(p.ws + WS_BIASC))[i] = a; }
}

__device__ __forceinline__ void ph_cmp2(const Params& p) {
    const bf16* HC = (const bf16*)(p.ws + WS_HC);
    const float* rc = (const float*)(p.ws + WS_ROPEC); const float* rs = (const float*)(p.ws + WS_ROPES);
    const int lane = tid_() & 63, wv = tid_() >> 6;
    for (int it = blockIdx.x * NWV + wv; it < 2 * 8 * NCMP; it += gridDim.x * NWV) {
        const int kv = it / (8 * NCMP), rem = it % (8 * NCMP), bh = rem / NCMP, n = rem % NCMP, b = bh >> 1;
        const float* w2 = kv ? p.in[18] : p.in[15];
        const bf16* h = HC + ((size_t)(kv * 8 + bh) * 512 + n) * 256;
        float acc = 0.f;
        for (int jj = 0; jj < 256; ++jj) acc = fmaf(bf2f(h[jj]), w2[jj * 64 + lane], acc);
        if (kv) { ((bf16*)(p.ws + WS_VCB))[((size_t)bh * 512 + n) * 64 + lane] = (bf16)f2bf(acc); continue; }
        const float r = rsqrtf(wave_sum(acc * acc) * (1.f / 64.f) + EPS);
        float y = acc * r * p.in[10][lane];
        const float yp = shx<8>(y);
        const int m = b * T_ + 16 * n + 31;
        if (lane < 16) { const float c = rc[m * 8 + (lane & 7)], s = rs[m * 8 + (lane & 7)]; y = (lane < 8) ? (y * c - yp * s) : (y * c + yp * s); }
        ((bf16*)(p.ws + WS_KCB))[((size_t)bh * 512 + n) * 64 + lane] = (bf16)f2bf(y);
    }
}

namespace fa {
typedef short bf16x8 __attribute__((ext_vector_type(8)));
typedef short s16x4 __attribute__((ext_vector_type(4)));
typedef float f32x16 __attribute__((ext_vector_type(16)));
typedef short v4i16_t __attribute__((ext_vector_type(4)));
typedef LAS const char* lptr;
typedef float f32x4v __attribute__((ext_vector_type(4)));
__device__ __forceinline__ int crow(int r, int hi) { return (r & 3) + 8 * (r >> 2) + 4 * hi; }
__device__ __forceinline__ unsigned cvtpk(float lo, float hi) { unsigned r; asm volatile("v_cvt_pk_bf16_f32 %0, %1, %2" : "=v"(r) : "v"(lo), "v"(hi)); return r; }
__device__ __forceinline__ unsigned wave_or(unsigned v) {
    int x = (int)v; x |= shxi<1>(x); x |= shxi<2>(x); x |= shxi<4>(x); x |= shxi<8>(x); x |= shxi<16>(x); x |= shxi<32>(x);
    return (unsigned)__builtin_amdgcn_readfirstlane(x);
}
struct KVRegs { v4u k, v; };
__device__ __forceinline__ void kv_load(KVRegs& r, const bf16* Kg, const bf16* Vg, int ldk, int ldv, int tid) {
    r.k = *(const v4u*)(Kg + (size_t)(tid >> 3) * ldk + (tid & 7) * 8);
    r.v = *(const v4u*)(Vg + (size_t)(tid >> 3) * ldv + (tid & 7) * 8);
}
__device__ __forceinline__ void kv_store(const KVRegs& r, LAS char* Kb, LAS char* Vb, int tid) {
    const int key = tid >> 3, c = tid & 7;
    *(LAS v4u*)(Kb + c * 1024 + ((key ^ c) * 16)) = r.k;
    *(LAS v4u*)(Vb + (c >> 2) * 4096 + key * 64 + (((c & 3) * 16) ^ (((key >> 2) & 1) << 5))) = r.v;
}
__device__ __forceinline__ void qk_tile(f32x16& p0, f32x16& p1, lptr Kb, const bf16x8 (&qf)[4], int r32, int hi) {
    lptr kb = Kb + hi * 1024;
    f32x16 a = {}, b = {};
#pragma unroll
    for (int d0 = 0; d0 < 4; ++d0) {
        const int ko = (r32 ^ (2 * d0 + hi)) * 16;
        const bf16x8 b0 = *(LAS const bf16x8*)(kb + d0 * 2048 + ko), b1 = *(LAS const bf16x8*)(kb + d0 * 2048 + 512 + ko);
        a = __builtin_amdgcn_mfma_f32_32x32x16_bf16(b0, qf[d0], a, 0, 0, 0);
        b = __builtin_amdgcn_mfma_f32_32x32x16_bf16(b1, qf[d0], b, 0, 0, 0);
    }
    p0 = a; p1 = b;
}
__device__ __forceinline__ void qk_tile_c(f32x16& p0, f32x16& p1, lptr Kb, const bf16x8 (&qf)[4], int r32, int hi, const f32x16& c) {
    lptr kb = Kb + hi * 1024;
    f32x16 a = c, b = c;
#pragma unroll
    for (int d0 = 0; d0 < 4; ++d0) {
        const int ko = (r32 ^ (2 * d0 + hi)) * 16;
        const bf16x8 b0 = *(LAS const bf16x8*)(kb + d0 * 2048 + ko), b1 = *(LAS const bf16x8*)(kb + d0 * 2048 + 512 + ko);
        a = __builtin_amdgcn_mfma_f32_32x32x16_bf16(b0, qf[d0], a, 0, 0, 0);
        b = __builtin_amdgcn_mfma_f32_32x32x16_bf16(b1, qf[d0], b, 0, 0, 0);
    }
    p0 = a; p1 = b;
}
__device__ __forceinline__ s16x4 vtr(lptr p) { return __builtin_bit_cast(s16x4, __builtin_amdgcn_ds_read_tr16_b64_v4i16((LAS v4i16_t*)p)); }
__device__ __forceinline__ void pv_tile(f32x16 (&o)[2], lptr Vb, const v4u (&pw)[4], int lane, int hi) {
    lptr vp = Vb + ((((lane >> 4) & 1) * 32) ^ (hi << 5)) + (lane & 3) * 8 + (4 * hi + ((lane & 15) >> 2)) * 64;
#pragma unroll
    for (int d0 = 0; d0 < 2; ++d0)
#pragma unroll
        for (int s = 0; s < 4; ++s) {
            const s16x4 lo = vtr(vp + d0 * 4096 + s * 1024), hh = vtr(vp + d0 * 4096 + s * 1024 + 512);
            const bf16x8 vf = {lo[0], lo[1], lo[2], lo[3], hh[0], hh[1], hh[2], hh[3]};
            o[d0] = __builtin_amdgcn_mfma_f32_32x32x16_bf16(__builtin_bit_cast(bf16x8, pw[s]), vf, o[d0], 0, 0, 0);
        }
}
__device__ __forceinline__ void pack_p(v4u (&pw)[4], const f32x16& p0, const f32x16& p1) {
    pw[0] = (v4u){cvtpk(p0[0], p0[1]), cvtpk(p0[2], p0[3]), cvtpk(p0[4], p0[5]), cvtpk(p0[6], p0[7])};
    pw[1] = (v4u){cvtpk(p0[8], p0[9]), cvtpk(p0[10], p0[11]), cvtpk(p0[12], p0[13]), cvtpk(p0[14], p0[15])};
    pw[2] = (v4u){cvtpk(p1[0], p1[1]), cvtpk(p1[2], p1[3]), cvtpk(p1[4], p1[5]), cvtpk(p1[6], p1[7])};
    pw[3] = (v4u){cvtpk(p1[8], p1[9]), cvtpk(p1[10], p1[11]), cvtpk(p1[12], p1[13]), cvtpk(p1[14], p1[15])};
}
__device__ __forceinline__ float max_abs64(const float* g, int lane) { return wave_max(fabsf(g[lane])); }
#define FA_BAR() do { asm volatile("s_waitcnt lgkmcnt(0)" ::: "memory"); __builtin_amdgcn_s_barrier(); asm volatile("" ::: "memory"); } while (0)

#define TOF_ID(n) (n)
#define KV_PIPE_D(DEPTH, CNT, TILE_OF, KG, VG, LDK, LDV, TSK, TSV, BODY) do { \
    KVRegs kq_[DEPTH]; const int cnt_ = (CNT); bool stop_ = false; \
    _Pragma("unroll") for (int k_ = 0; k_ < (DEPTH); ++k_) if (k_ < cnt_) { const int jj_ = TILE_OF(k_); kv_load(kq_[k_], (KG) + (size_t)jj_ * (TSK), (VG) + (size_t)jj_ * (TSV), (LDK), (LDV), tid); } \
    _Pragma("unroll 1") for (int n_ = 0; n_ < cnt_ && !stop_; n_ += (DEPTH)) { \
        _Pragma("unroll") for (int k_ = 0; k_ < (DEPTH); ++k_) { if (n_ + k_ < cnt_ && !stop_) { \
            const int j = TILE_OF(n_ + k_); \
            LAS char* Kb = L + (it & 1) * 8192; LAS char* Vb = L + 16384 + (it & 1) * 8192; ++it; \
            kv_store(kq_[k_], Kb, Vb, tid); FA_BAR(); \
            if (n_ + k_ + (DEPTH) < cnt_) { const int jn_ = TILE_OF(n_ + k_ + (DEPTH)); kv_load(kq_[k_], (KG) + (size_t)jn_ * (TSK), (VG) + (size_t)jn_ * (TSV), (LDK), (LDV), tid); } \
            BODY \
        } } } } while (0)
}


struct VcuMap { const unsigned* tab; bool ok; __device__ __forceinline__ int operator()(int c) const { return ok ? (int)tab[c] : c; } };
__device__ __forceinline__ VcuMap vcu_map(const Params& p) {
    const unsigned* ctl = (const unsigned*)(p.ws + WS_CTL);
    unsigned bad = gridDim.x == 256 ? 0u : 1u;
    unsigned v[8];
#pragma unroll
    for (int x = 0; x < 8; ++x) v[x] = __hip_atomic_load(ctl + CW_XRANK + 64 * x, __ATOMIC_RELAXED, __HIP_MEMORY_SCOPE_AGENT);
#pragma unroll
    for (int x = 0; x < 8; ++x) bad |= v[x] ^ 32u;
    return VcuMap{ctl + CW_VCU, bad == 0u};
}
#define BODY_CMP \
{ \
                f32x16 p0, p1; qk_tile_c(p0, p1, Kb, qf, r32, hi, negM2v);        \
                if (64 * j + 64 <= nvmin) {                                         \
_Pragma("unroll") \
                    for (int r = 0; r < 16; ++r) { p0[r] = __builtin_amdgcn_exp2f(p0[r]); p1[r] = __builtin_amdgcn_exp2f(p1[r]); } \
                } else { \
                    const int nb = 64 * j + 4 * hi; \
_Pragma("unroll") \
                    for (int r = 0; r < 16; ++r) { \
                        const int n0 = nb + (r & 3) + 8 * (r >> 2), n1 = n0 + 32; \
                        p0[r] = n0 < nv ? __builtin_amdgcn_exp2f(p0[r]) : 0.f; p1[r] = n1 < nv ? __builtin_amdgcn_exp2f(p1[r]) : 0.f; \
                    } \
                } \
                if (pass == 0) { \
                    float s0 = 0.f, s1 = 0.f, s2 = 0.f, s3 = 0.f; \
_Pragma("unroll") \
                    for (int r = 0; r < 16; r += 2) { s0 += p0[r]; s1 += p0[r + 1]; s2 += p1[r]; s3 += p1[r + 1]; } \
                    l += (s0 + s1) + (s2 + s3); \
                } else {                                                            \
                    v4u pw[4]; pack_p(pw, p0, p1); \
                    pv_tile(o, Vb, pw, lane, hi); \
_Pragma("unroll") \
                    for (int k = 0; k < 8; ++k) { \
                            const f32x16& P = (k >> 2) ? p1 : p0; const int uu = k & 3; \
                            float bb = hinv * P[4 * uu + 3], a = fmaf((P[4 * uu] + P[4 * uu + 1]) + P[4 * uu + 2], inv, bb); \
                            a += shx<1>(a); a += shx<2>(a); bb += shx<1>(bb); bb += shx<2>(bb); \
                            const float pbb = shx<32>(bb); \
                            a += hi ? pbb : prevp; prevp = pbb; \
                            if (g == 0) IMP[tkl * IMPS + 16 * j + hi + (k >> 2) * 8 + (k & 3) * 2 - 1] = a; \
                    } \
                } \
            }
namespace fa {
__device__ __forceinline__ void store_tile_bf16(LAS float* stg, const f32x16 (&o)[2], const LAS float* wsf, int lane, int r32, int hi, bf16* base, int s_hi, int s_lo) {
    LDS_FENCE();
#pragma unroll
    for (int r = 0; r < 16; ++r) { const int q = crow(r, hi); const float f = wsf ? wsf[q] : 1.0f; stg[q * 64 + r32] = f * o[0][r]; stg[q * 64 + 32 + r32] = f * o[1][r]; }
    LDS_FENCE();
#pragma unroll
    for (int k = 0; k < 4; ++k) {
        const int q = 8 * k + (lane >> 3), ch = lane & 7;
        const f32x4v a0 = *(LAS const f32x4v*)(stg + q * 64 + ch * 8), a1 = *(LAS const f32x4v*)(stg + q * 64 + ch * 8 + 4);
        v4u ov; ov.x = cvtpk(a0[0], a0[1]); ov.y = cvtpk(a0[2], a0[3]); ov.z = cvtpk(a1[0], a1[1]); ov.w = cvtpk(a1[2], a1[3]);
        *(v4u*)(base + (size_t)(q >> 2) * s_hi + (q & 3) * s_lo + ch * 8) = ov;
    }
    LDS_FENCE();
}
}
namespace fa {
__device__ __forceinline__ int red8_add(int x) {
    x += __builtin_amdgcn_mov_dpp(x, 0xB1, 0xf, 0xf, true); x += __builtin_amdgcn_mov_dpp(x, 0x4E, 0xf, 0xf, true); x += __builtin_amdgcn_mov_dpp(x, 0x141, 0xf, 0xf, true); return x; }
__device__ __forceinline__ int red8_or(int x) {
    x |= __builtin_amdgcn_mov_dpp(x, 0xB1, 0xf, 0xf, true); x |= __builtin_amdgcn_mov_dpp(x, 0x4E, 0xf, 0xf, true); x |= __builtin_amdgcn_mov_dpp(x, 0x141, 0xf, 0xf, true); return x; }
}
template <int ABL = 0>
__device__ __forceinline__ void ph_nsa_cmp_fast(const Params& p, float* ldsf) {
    using namespace fa;
    LAS char* L = (LAS char*)ldsf;
    constexpr int IMPS = 127;
    const int tid = tid_(), lane = tid & 63, w = __builtin_amdgcn_readfirstlane(tid >> 6), r32 = lane & 31, hi = lane >> 5;
    LAS float* IMP = (LAS float*)(L + 131072 + 16);
    const bf16* QN = (const bf16*)(p.ws + WS_QN); const float* GATES = (const float*)(p.ws + WS_GATES); unsigned* SELM = (unsigned*)(p.ws + WS_SELM);
    bf16* OCB = ABL ? (bf16*)p.out : (bf16*)(p.ws + WS_OCB); if (ABL) SELM = (unsigned*)p.out + (16u << 20);
    const float* gmax = (const float*)(p.ws + WS_GMAX); const float gq = gmax[0], gkc = gmax[1];
    const float M2 = fminf(8.08f * gq * gkc, 40.f) * 1.4426950408889634f;
    f32x16 negM2v;
#pragma unroll
    for (int i = 0; i < 16; ++i) negM2v[i] = -M2;
    const VcuMap vcu_of = vcu_map(p);
    int bh_res = -1;
    for (int u = blockIdx.x; u < 1024; u += gridDim.x) {
        const int u4 = u >> 8, c = vcu_of(u & 255), ci = c & 31;
        const int bh = c >> 5, tl = u4 == 0 ? ci : u4 == 1 ? 63 - ci : u4 == 2 ? 64 + ci : 127 - ci;
        const int b = bh >> 1, hk = bh & 1, t0 = tl * 64, cur = tl;
        const int tkl = 8 * w + (r32 >> 2), tq = t0 + tkl, g = r32 & 3, m = b * T_ + tq;
        bf16x8 qf[4];
#pragma unroll
        for (int d0 = 0; d0 < 4; ++d0) qf[d0] = *(const bf16x8*)(QN + (size_t)m * 512 + (hk * 4 + g) * 64 + 16 * d0 + 8 * hi);
        const float gate = GATES[(size_t)m * 24 + hk * 12 + g * 3 + 0];
        if (bh != bh_res) {
            const bf16* KC = (const bf16*)(p.ws + WS_KCB) + (size_t)bh * 512 * 64; const bf16* VC = (const bf16*)(p.ws + WS_VCB) + (size_t)bh * 512 * 64;
            __syncthreads();
#pragma unroll
            for (int h4 = 0; h4 < 2; ++h4) { KVRegs kq[4];
#pragma unroll
                for (int j = 0; j < 4; ++j) kv_load(kq[j], KC + (size_t)(4 * h4 + j) * 4096, VC + (size_t)(4 * h4 + j) * 4096, 64, 64, tid);
#pragma unroll
                for (int j = 0; j < 4; ++j) kv_store(kq[j], L + (4 * h4 + j) * 8192, L + 65536 + (4 * h4 + j) * 8192, tid); }
            FA_BAR(); bh_res = bh;
        }
        const int nv = tq >= 31 ? (tq - 31) / 16 + 1 : 0;
        const int nvmax = (t0 + 63 - 31) / 16 + 1, ntile = ABL == 2 ? 0 : t0 + 63 >= 31 ? (nvmax + 63) >> 6 : 0;
        const int tw0 = t0 + 8 * w, nvmin = tw0 >= 31 ? (tw0 - 31) / 16 + 1 : 0;
        float l = 0.f, inv = 0.f, hinv = 0.f;
        f32x16 o[2] = {f32x16{}, f32x16{}};
#pragma unroll 1
        for (int pass = 0; pass < 2; ++pass) {
            float prevp = 0.f;
#pragma unroll 1
            for (int j = 0; j < ntile; ++j) { lptr Kb = L + j * 8192; lptr Vb = L + 65536 + j * 8192; BODY_CMP }
            if (pass == 0) { l += shx<32>(l); inv = l > 0.f ? 1.0f / l : 0.f; hinv = 0.5f * inv; }
        }
        {
            const float gcl = gate * inv;
#pragma unroll
            for (int r = 0; r < 16; ++r) {
                const int q0 = (r & 3) + 8 * (r >> 2);
                const float g0 = __builtin_bit_cast(float, __builtin_amdgcn_readlane(__builtin_bit_cast(int, gcl), q0)), g1 = __builtin_bit_cast(float, __builtin_amdgcn_readlane(__builtin_bit_cast(int, gcl), q0 + 4));
                const int q = crow(r, hi), tk = t0 + 8 * w + (q >> 2), gg = q & 3; const float gc = hi ? g1 : g0;
#pragma unroll
                for (int d0 = 0; d0 < 2; ++d0) OCB[(size_t)(b * T_ + tk) * 512 + hk * 256 + gg * 64 + 32 * d0 + r32] = (bf16)f2bf(gc * o[d0][r]);
            }
        }
        LDS_FENCE();
        const int nf = cur + 1 < 3 ? cur + 1 : 3, need = 16 - nf, ncand = cur - 2 > 0 ? cur - 2 : 0;
        if (ABL != 1) {
            const int tk = lane >> 3, sub = lane & 7;
            const LAS float* rowp = IMP + (8 * w + tk) * IMPS;
            unsigned selw[4] = {0u, 0u, 0u, 0u};
            bool conflict = false;
            if (ncand > need) {
                unsigned uu[16];
#pragma unroll
                for (int i = 0; i < 16; ++i) { const int j = sub + 8 * i; uu[i] = (j >= 1 && j <= cur - 2) ? __float_as_uint(rowp[j - 1]) : 0u; }
                unsigned thr = 0u; bool done = false;
#pragma unroll 1
                for (int bit = 30; bit >= 0; --bit) {
                    const unsigned cd = thr | (1u << bit);
                    int cnt = 0;
#pragma unroll
                    for (int i = 0; i < 16; ++i) cnt += (uu[i] >= cd) ? 1 : 0;
                    cnt = red8_add(cnt);
                    thr = (!done && cnt >= need) ? cd : thr; done = done || cnt == need;
                    if (__ballot(!done) == 0ull) break;
                }
                int cg = 0, ce = 0;
#pragma unroll
                for (int i = 0; i < 16; ++i) { const int j = sub + 8 * i; const bool cand = j >= 1 && j <= cur - 2; cg += (uu[i] > thr) ? 1 : 0; ce += (cand && uu[i] == thr) ? 1 : 0; }
                cg = red8_add(cg); ce = red8_add(ce);
                conflict = ce != need - cg;
#pragma unroll
                for (int i = 0; i < 16; ++i) { const int j = sub + 8 * i; const bool cand = j >= 1 && j <= cur - 2; if (uu[i] > thr || (cand && uu[i] == thr)) selw[i >> 2] |= 1u << (sub + 8 * (i & 3)); }
            } else {
#pragma unroll
                for (int i = 0; i < 16; ++i) { const int j = sub + 8 * i; if (j >= 1 && j <= cur - 2) selw[i >> 2] |= 1u << (sub + 8 * (i & 3)); }
            }
#pragma unroll
            for (int i = 0; i < 16; ++i) { const int j = sub + 8 * i; if (j <= cur && (j == 0 || j == cur || j == cur - 1)) selw[i >> 2] |= 1u << (sub + 8 * (i & 3)); }
#pragma unroll
            for (int k = 0; k < 4; ++k) selw[k] = (unsigned)red8_or((int)selw[k]);
            if (sub == 0) { v4u mk; mk.x = selw[0]; mk.y = selw[1]; mk.z = selw[2]; mk.w = selw[3]; *(v4u*)(SELM + ((size_t)bh * T_ + t0 + 8 * w + tk) * 4) = mk; }
            const unsigned long long cmask = __ballot(conflict);
            if (cmask != 0ull) {
                const unsigned long long ltmask = (1ull << lane) - 1ull;
#pragma unroll 1
                for (int t8 = 0; t8 < 8; ++t8) {
                    if (((cmask >> (8 * t8)) & 1ull) == 0ull) continue;
                    const LAS float* row = IMP + (8 * w + t8) * IMPS;
                    const int j0 = lane, j1 = lane + 64;
                    const bool c0 = j0 >= 1 && j0 <= cur - 2, c1 = j1 <= cur - 2;
                    const unsigned u0 = c0 ? __float_as_uint(row[j0 - 1]) : 0u, u1 = c1 ? __float_as_uint(row[j1 - 1]) : 0u;
                    unsigned thr = 0u;
#pragma unroll 1
                    for (int bit = 30; bit >= 0; --bit) {
                        const unsigned cd = thr | (1u << bit);
                        const int cnt = __popcll(__ballot(u0 >= cd)) + __popcll(__ballot(u1 >= cd));
                        if (cnt >= need) thr = cd;
                    }
                    const bool g0 = c0 && u0 > thr, g1 = c1 && u1 > thr, e0 = c0 && u0 == thr, e1 = c1 && u1 == thr;
                    const int rem = need - (__popcll(__ballot(g0)) + __popcll(__ballot(g1)));
                    const unsigned long long b0 = __ballot(e0), b1 = __ballot(e1);
                    bool s0 = g0 || (e0 && __popcll(b0 & ltmask) < rem);
                    bool s1 = g1 || (e1 && __popcll(b0) + __popcll(b1 & ltmask) < rem);
                    s0 = s0 || (j0 <= cur && (j0 == 0 || j0 == cur || j0 == cur - 1));
                    s1 = s1 || (j1 <= cur && (j1 == cur || j1 == cur - 1));
                    const unsigned long long mlo = __ballot(s0), mhi = __ballot(s1);
                    if (lane == 0) { v4u mk; mk.x = (unsigned)mlo; mk.y = (unsigned)(mlo >> 32); mk.z = (unsigned)mhi; mk.w = (unsigned)(mhi >> 32);
                        asm volatile("s_waitcnt vmcnt(0)" ::: "memory");
                        *(v4u*)(SELM + ((size_t)bh * T_ + t0 + 8 * w + t8) * 4) = mk; }
                }
            }
        }
    }
}

#define TOF_SB(n) (ktop - (n))
namespace fa {
template <bool MASK>
__device__ __forceinline__ void sb_tile(f32x16& p0, f32x16& p1, float& Rl, int tq, int kb, int hi) {
    f32x16 l0, l1;
#pragma unroll
    for (int r = 0; r < 16; ++r) {
        float c0 = __builtin_amdgcn_rcpf(1.0f + __builtin_amdgcn_exp2f(p0[r])), c1 = __builtin_amdgcn_rcpf(1.0f + __builtin_amdgcn_exp2f(p1[r]));
        if (MASK) { const int k0 = kb + (r & 3) + 8 * (r >> 2); c0 = k0 < tq ? c0 : 1.0f; c1 = k0 + 32 < tq ? c1 : 1.0f; }
        l0[r] = c0; l1[r] = c1;
    }
    float tot[8], pto[8];
#pragma unroll
    for (int k = 0; k < 8; ++k) { const f32x16& X = (k >> 2) ? l1 : l0; const int r0 = 4 * (k & 3); tot[k] = (X[r0] * X[r0 + 1]) * (X[r0 + 2] * X[r0 + 3]); pto[k] = shx<32>(tot[k]); }
    float above = Rl;
#pragma unroll
    for (int k = 7; k >= 0; --k) {
        f32x16& X = (k >> 2) ? l1 : l0; f32x16& Z = (k >> 2) ? p1 : p0; const int r0 = 4 * (k & 3);
        const float ab = hi == 0 ? above * pto[k] : above;
        const float x3 = X[r0 + 3], x2 = X[r0 + 2], x1 = X[r0 + 1], x0 = X[r0];
        const float f3 = ab, f2 = f3 * x3, f1 = f2 * x2, f0 = f1 * x1;
        Z[r0 + 3] = f3 - f3 * x3; Z[r0 + 2] = f2 - f2 * x2; Z[r0 + 1] = f1 - f1 * x1; Z[r0] = f0 - f0 * x0;
        above *= tot[k] * pto[k];
    }
    Rl = above;
}
}
#define BODY_SB \
{ \
            int alld = 1; \
_Pragma("unroll") \
            for (int i = 0; i < 8; ++i) alld &= flags[((it - 1) & 1) * 8 + i]; \
            if (alld) { stop_ = true; } \
            else { \
            const int kt = j; \
            if (!done && 64 * kt <= trow + 30) { \
                f32x16 p0, p1; qk_tile(p0, p1, Kb, qf, r32, hi); \
                const int kb = 64 * kt + 4 * hi; \
                if (64 * kt + 63 >= trow) sb_tile<true>(p0, p1, R, tq, kb, hi); else sb_tile<false>(p0, p1, R, tq, kb, hi); \
                v4u pw[4]; pack_p(pw, p0, p1); \
                pv_tile(o, Vb, pw, lane, hi); \
                done = __all(R < 8.5e-27f) || kt == 0; \
            } \
            if (lane == 0) flags[(it & 1) * 8 + w] = done ? 1 : 0; \
        } }
__device__ __forceinline__ void ph_sb_fast(const Params& p, float* ldsf) {
    using namespace fa;
    LAS char* L = (LAS char*)ldsf;
    const int tid = tid_(), lane = tid & 63, w = __builtin_amdgcn_readfirstlane(tid >> 6), r32 = lane & 31, hi = lane >> 5, hsel = w >> 2;
    volatile LAS int* flags = (volatile LAS int*)(L + 65536);
    const bf16* QS = (const bf16*)(p.ws + WS_QS); bf16* MIX = (bf16*)(p.ws + WS_MIX);
    int it = 0;
    unsigned* qhead = (unsigned*)(p.ws + WS_CTL) + CW_SBQ;
    int unext = 0;
    if (tid == 0) unext = (int)__hip_atomic_fetch_add(qhead, 1u, __ATOMIC_RELAXED, __HIP_MEMORY_SCOPE_AGENT);
    for (;;) {
        if (tid == 0) flags[16] = unext;
        FA_BAR();
        const int u = flags[16];
        if (u >= 1024) break;
        if (tid == 0) unext = (int)__hip_atomic_fetch_add(qhead, 1u, __ATOMIC_RELAXED, __HIP_MEMORY_SCOPE_AGENT);
        const int bhp = u >> 6, tl = u & 63, b = bhp >> 2, hp = bhp & 3, t0 = tl * 128, h = 2 * hp + hsel, trow = t0 + 32 * (w & 3);
        const bf16* Kg0 = (const bf16*)(p.ws + WS_KSB) + (size_t)(b * 8 + 2 * hp) * T_ * 64; const bf16* Vg0 = (const bf16*)(p.ws + WS_VSB) + (size_t)(b * 8 + 2 * hp) * T_ * 64;
        const int tq = trow + r32, m = b * T_ + tq;
        bf16x8 qf[4];
#pragma unroll
        for (int d0 = 0; d0 < 4; ++d0) qf[d0] = *(const bf16x8*)(QS + (size_t)m * 512 + h * 64 + 16 * d0 + 8 * hi);
        f32x16 o[2] = {f32x16{}, f32x16{}};
        float R = 1.0f; bool done = false;
        const int ktop = (t0 + 126) >> 6, cnt = ktop + 1;
        if (lane == 0) { flags[w] = 0; flags[8 + w] = 0; }
        {
            KVRegs kq[2][2]; bool stop_ = false;
#pragma unroll
            for (int k_ = 0; k_ < 2; ++k_) if (k_ < cnt) { const int jj = ktop - k_;
#pragma unroll
                for (int hh = 0; hh < 2; ++hh) kv_load(kq[k_][hh], Kg0 + (size_t)hh * T_ * 64 + (size_t)jj * 4096, Vg0 + (size_t)hh * T_ * 64 + (size_t)jj * 4096, 64, 64, tid); }
#pragma unroll 1
            for (int n_ = 0; n_ < cnt && !stop_; n_ += 2) {
#pragma unroll
                for (int k_ = 0; k_ < 2; ++k_) { if (n_ + k_ < cnt && !stop_) {
                    const int j = ktop - (n_ + k_);
                    LAS char* Sb = L + (it & 1) * 32768; ++it;
#pragma unroll
                    for (int hh = 0; hh < 2; ++hh) kv_store(kq[k_][hh], Sb + hh * 16384, Sb + hh * 16384 + 8192, tid);
                    FA_BAR();
                    if (n_ + k_ + 2 < cnt) { const int jn = ktop - (n_ + k_ + 2);
#pragma unroll
                        for (int hh = 0; hh < 2; ++hh) kv_load(kq[k_][hh], Kg0 + (size_t)hh * T_ * 64 + (size_t)jn * 4096, Vg0 + (size_t)hh * T_ * 64 + (size_t)jn * 4096, 64, 64, tid); }
                    LAS char* Kb = Sb + hsel * 16384; LAS char* Vb = Kb + 8192;
                    BODY_SB
                } }
            }
        }
#pragma unroll
        for (int r = 0; r < 16; ++r) {
            const size_t mo = (size_t)(b * T_ + trow + crow(r, hi));
#pragma unroll
            for (int d0 = 0; d0 < 2; ++d0) MIX[mo * D_ + 512 + h * 64 + 32 * d0 + r32] = (bf16)f2bf(o[d0][r]);
        }
        FA_BAR();
    }
}

#define BODY_MEM \
{ \
            f32x16 p0, p1; qk_tile(p0, p1, Kb, qf, r32, hi); \
            float ls = 0.f; \
_Pragma("unroll") \
            for (int r = 0; r < 16; ++r) { const float e0 = __builtin_amdgcn_exp2f(p0[r] - M2), e1 = __builtin_amdgcn_exp2f(p1[r] - M2); p0[r] = e0; p1[r] = e1; ls += e0 + e1; } \
            l += ls; \
            v4u pw[4]; pack_p(pw, p0, p1); \
            pv_tile(o, Vb, pw, lane, hi); \
        }
__device__ __forceinline__ void ph_memattn_fast(const Params& p, float* ldsf) {
    using namespace fa;
    LAS char* L = (LAS char*)ldsf;
    const int tid = tid_(), lane = tid & 63, w = __builtin_amdgcn_readfirstlane(tid >> 6), r32 = lane & 31, hi = lane >> 5;
    LAS float* wsf = (LAS float*)(L + 32768) + w * 64;
    const bf16* QM = (const bf16*)(p.ws + WS_QMEM); bf16* OM = (bf16*)(p.ws + WS_OMEM);
    const float* gmax = (const float*)(p.ws + WS_GMAX); const float M2 = fminf(8.08f * gmax[4] * gmax[5], 40.f) * 1.4426950408889634f;
    int it = 0;
    for (int u = blockIdx.x; u < 512; u += gridDim.x) {
        const int tl = u & 31, h = (u >> 5) & 3, b = u >> 7, t0 = tl * 256;
        const bf16* Kg = (const bf16*)(p.ws + WS_KMEM) + (size_t)b * MEM_ * 256 + h * 64; const bf16* Vg = (const bf16*)(p.ws + WS_VMEM) + (size_t)b * MEM_ * 256 + h * 64;
        const int m = b * T_ + t0 + 32 * w + r32;
        bf16x8 qf[4];
#pragma unroll
        for (int d0 = 0; d0 < 4; ++d0) qf[d0] = *(const bf16x8*)(QM + (size_t)m * 256 + h * 64 + 16 * d0 + 8 * hi);
        f32x16 o[2] = {f32x16{}, f32x16{}}; float l = 0.f;
        KV_PIPE_D(4, 4, TOF_ID, Kg, Vg, 256, 256, 64 * 256, 64 * 256, BODY_MEM);
        l += shx<32>(l);
        LDS_FENCE();
        if (hi == 0) wsf[r32] = 1.0f / l;
        LDS_FENCE();
        store_tile_bf16((LAS float*)(L + 36864) + w * 2048, o, wsf, lane, r32, hi, OM + (size_t)(b * T_ + t0 + 32 * w) * 256 + h * 64, 4 * 256, 256);
    }
}

namespace fa {
__device__ __forceinline__ void qk_tile_m(f32x16& p0, f32x16& p1, lptr Kb, const bf16x8 (&qf)[4], int r32, int hi, const f32x16& negm) {
    lptr kb = Kb + hi * 1024;
    f32x16 a, b;
#pragma unroll
    for (int d0 = 0; d0 < 4; ++d0) {
        const int ko = (r32 ^ (2 * d0 + hi)) * 16;
        const bf16x8 b0 = *(LAS const bf16x8*)(kb + d0 * 2048 + ko), b1 = *(LAS const bf16x8*)(kb + d0 * 2048 + 512 + ko);
        if (d0 == 0) { a = __builtin_amdgcn_mfma_f32_32x32x16_bf16(b0, qf[0], negm, 0, 0, 0); b = __builtin_amdgcn_mfma_f32_32x32x16_bf16(b1, qf[0], negm, 0, 0, 0); }
        else { a = __builtin_amdgcn_mfma_f32_32x32x16_bf16(b0, qf[d0], a, 0, 0, 0); b = __builtin_amdgcn_mfma_f32_32x32x16_bf16(b1, qf[d0], b, 0, 0, 0); }
    }
    p0 = a; p1 = b;
}
template <bool CMP, bool WIN>
__device__ __forceinline__ float softmax_tile(f32x16& p0, f32x16& p1, bool lanebit, int kb, int tq) {
    float ls = 0.f;
#pragma unroll
    for (int r = 0; r < 16; ++r) {
        float e0 = __builtin_amdgcn_exp2f(p0[r]), e1 = __builtin_amdgcn_exp2f(p1[r]);
        if (CMP) { const int k0 = kb + (r & 3) + 8 * (r >> 2), k1 = k0 + 32; e0 = (k0 <= tq && (!WIN || tq - k0 < 512)) ? e0 : 0.f; e1 = (k1 <= tq && (!WIN || tq - k1 < 512)) ? e1 : 0.f; }
        p0[r] = e0; p1[r] = e1; ls += e0 + e1;
    }
    return lanebit ? ls : 0.f;
}
}
#define SW5_TILE(PA0, PA1, J, SLOT) do { \
    const int kb_ = 64 * (J) + 4 * hi; \
    const bool lb_ = BR ? true : ((((J) < 64 ? mlo : mhi) >> ((J) & 63)) & 1ull) != 0ull; \
    const bool cmp_ = BR ? ((J) == cur || (J) + 8 == cur) : ((J) == cur); \
    if (cmp_) (void)softmax_tile<true, BR != 0>(PA0, PA1, lb_, kb_, tq); else (void)softmax_tile<false, BR != 0>(PA0, PA1, lb_, kb_, tq); \
    v4u pw_[4]; pack_p(pw_, PA0, PA1); \
    if (!BR) { _Pragma("unroll") for (int s_ = 0; s_ < 4; ++s_) { pw_[s_].x = lb_ ? pw_[s_].x : 0u; pw_[s_].y = lb_ ? pw_[s_].y : 0u; pw_[s_].z = lb_ ? pw_[s_].z : 0u; pw_[s_].w = lb_ ? pw_[s_].w : 0u; } } \
    { const bf16x8 ones_ = {0x3F80, 0x3F80, 0x3F80, 0x3F80, 0x3F80, 0x3F80, 0x3F80, 0x3F80};        \
      _Pragma("unroll") for (int s_ = 0; s_ < 4; ++s_) lacc = __builtin_amdgcn_mfma_f32_32x32x16_bf16(__builtin_bit_cast(bf16x8, pw_[s_]), ones_, lacc, 0, 0, 0); } \
    pv_tile(o, (SLOT) + 8192, pw_, lane, hi); } while (0)
namespace fa {
__device__ __forceinline__ void kv_dma(const bf16* Kg, const bf16* Vg, LAS char* Sl, int w, int lane) {
    __builtin_amdgcn_global_load_lds((const unsigned*)(Kg + (size_t)(lane ^ w) * 64 + w * 8), (LAS unsigned*)(Sl + w * 1024), 16, 0, 0);
    __builtin_amdgcn_global_load_lds((const unsigned*)(Vg + (size_t)(16 * (w & 3) + (lane >> 2)) * 64 + (w >> 2) * 32 + (((lane & 3) * 8) ^ (((lane >> 4) & 1) << 4))), (LAS unsigned*)(Sl + 8192 + w * 1024), 16, 0, 0);
}
#define FA_BAR_VM0() do { asm volatile("s_waitcnt vmcnt(0) lgkmcnt(0)" ::: "memory"); __builtin_amdgcn_s_barrier(); asm volatile("" ::: "memory"); } while (0)
}
template <int BR, bool PIPE = true>
__device__ __forceinline__ void sw6_branch(fa::f32x16 (&o)[2], fa::f32x16& lacc, LAS char* L, int& it, const bf16* Kg, const bf16* Vg, const fa::bf16x8 (&qf)[4], unsigned long long mlo, unsigned long long mhi,
                                           int cur, int tq, float negM2s, int w, int lane, int r32, int hi, unsigned long long wlo, unsigned long long whi) {
    using namespace fa;
    f32x16 negM2;
#pragma unroll
    for (int r = 0; r < 16; ++r) negM2[r] = negM2s;
    asm volatile("" : "+v"(negM2));
    const int j0 = BR ? (cur >= 8 ? cur - 8 : 0) : 0;
    {   LAS char* S0 = L + (it & 1) * 32768;
        kv_dma(Kg + (size_t)j0 * 4096, Vg + (size_t)j0 * 4096, S0, w, lane);
        if (j0 + 1 <= cur) kv_dma(Kg + (size_t)(j0 + 1) * 4096, Vg + (size_t)(j0 + 1) * 4096, S0 + 16384, w, lane); }
#pragma unroll 1
    for (int base = j0; base <= cur; base += 2, ++it) {
        const bool two = base + 1 <= cur;
        LAS char* S0 = L + (it & 1) * 32768; LAS char* S1 = L + ((it + 1) & 1) * 32768;
        FA_BAR_VM0();
        if (base + 2 <= cur) kv_dma(Kg + (size_t)(base + 2) * 4096, Vg + (size_t)(base + 2) * 4096, S1, w, lane);
        if (base + 3 <= cur) kv_dma(Kg + (size_t)(base + 3) * 4096, Vg + (size_t)(base + 3) * 4096, S1 + 16384, w, lane);
        if (PIPE) {
            f32x16 pa0, pa1; qk_tile_m(pa0, pa1, S0, qf, r32, hi, negM2);
            if (two) {
                f32x16 pb0, pb1; qk_tile_m(pb0, pb1, S0 + 16384, qf, r32, hi, negM2);
                SW5_TILE(pa0, pa1, base, S0);
                SW5_TILE(pb0, pb1, base + 1, S0 + 16384);
            } else {
                SW5_TILE(pa0, pa1, base, S0);
            }
        } else {
#pragma unroll 1
            for (int i = 0; i < (two ? 2 : 1); ++i) {
                LAS char* Sl = S0 + i * 16384; const int jj = base + i;
                f32x16 pa0, pa1; qk_tile_m(pa0, pa1, Sl, qf, r32, hi, negM2);
                SW5_TILE(pa0, pa1, jj, Sl);
            }
        }
    }
}

template <int BR>
__device__ __forceinline__ void sw8_branch(fa::f32x16 (&o)[2], fa::f32x16& lacc, LAS char* L, int& it, const bf16* Kg, const bf16* Vg, const fa::bf16x8 (&qf)[4], unsigned long long mlo, unsigned long long mhi,
                                           int cur, int tq, float negM2s, int w, int lane, int r32, int hi, unsigned long long wlo, unsigned long long whi) {
    using namespace fa;
    f32x16 negM2;
#pragma unroll
    for (int r = 0; r < 16; ++r) negM2[r] = negM2s;
    asm volatile("" : "+v"(negM2));
    const int j0 = BR ? (cur >= 8 ? cur - 8 : 0) : 0;
    {   LAS char* S0 = L + (it & 1) * 65536;
#pragma unroll
        for (int i = 0; i < 4; ++i) if (j0 + i <= cur) kv_dma(Kg + (size_t)(j0 + i) * 4096, Vg + (size_t)(j0 + i) * 4096, S0 + i * 16384, w, lane); }
#pragma unroll 1
    for (int base = j0; base <= cur; base += 4, ++it) {
        LAS char* S0 = L + (it & 1) * 65536; LAS char* S1 = L + ((it + 1) & 1) * 65536;
        FA_BAR_VM0();
#pragma unroll
        for (int i = 0; i < 4; ++i) if (base + 4 + i <= cur) kv_dma(Kg + (size_t)(base + 4 + i) * 4096, Vg + (size_t)(base + 4 + i) * 4096, S1 + i * 16384, w, lane);
        const int ni = cur - base + 1 < 4 ? cur - base + 1 : 4;
#pragma unroll 1
        for (int i = 0; i < ni; ++i) {
            LAS char* Sl = S0 + i * 16384; const int jj = base + i;
            if (!BR && (((jj < 64 ? wlo : whi) >> (jj & 63)) & 1ull) == 0ull) continue;
            f32x16 pa0, pa1; qk_tile_m(pa0, pa1, Sl, qf, r32, hi, negM2);
            SW5_TILE(pa0, pa1, jj, Sl);
        }
    }
}

__device__ __forceinline__ void ph_nsa_selwin6(const Params& p, float* ldsf) {
    using namespace fa;
    LAS char* L = (LAS char*)ldsf;
    constexpr int OFF_WSF = 131072, OFF_STG = 65536;
    const int tid = tid_(), lane = tid & 63, w = __builtin_amdgcn_readfirstlane(tid >> 6), r32 = lane & 31, hi = lane >> 5;
    LAS float* wsf = (LAS float*)(L + OFF_WSF) + w * 64;
    const bf16* QN = (const bf16*)(p.ws + WS_QN); const float* GATES = (const float*)(p.ws + WS_GATES); const unsigned* SELM = (const unsigned*)(p.ws + WS_SELM);
    const bf16* OCB = (const bf16*)(p.ws + WS_OCB); bf16* MIX = (bf16*)(p.ws + WS_MIX);
    const float* gmax = (const float*)(p.ws + WS_GMAX); const float gq = gmax[0], gks = gmax[2], gkw = gmax[3];
    const float M2s = fminf(8.08f * gq * gks, 40.f) * 1.4426950408889634f, M2w = fminf(8.08f * gq * gkw, 40.f) * 1.4426950408889634f;
    const VcuMap vcu_of = vcu_map(p);
    for (int u = blockIdx.x; u < 1024; u += gridDim.x) {
        const int u4 = u >> 8, c = vcu_of(u & 255), ci = c & 31;
        const int bh = c >> 5, tl = u4 == 0 ? ci : u4 == 1 ? 63 - ci : u4 == 2 ? 64 + ci : 127 - ci;
        const int b = bh >> 1, hk = bh & 1, t0 = tl * 64, cur = tl;
        const int tq = t0 + 8 * w + (r32 >> 2), g = r32 & 3, m = b * T_ + tq;
        bf16x8 qf[4];
#pragma unroll
        for (int d0 = 0; d0 < 4; ++d0) qf[d0] = *(const bf16x8*)(QN + (size_t)m * 512 + (hk * 4 + g) * 64 + 16 * d0 + 8 * hi);
        const v4u mk = *(const v4u*)(SELM + ((size_t)bh * T_ + tq) * 4);
        const unsigned long long mlo = (unsigned long long)mk.x | ((unsigned long long)mk.y << 32), mhi = (unsigned long long)mk.z | ((unsigned long long)mk.w << 32);
        const unsigned long long wlo = (unsigned long long)wave_or(mk.x) | ((unsigned long long)wave_or(mk.y) << 32), whi = (unsigned long long)wave_or(mk.z) | ((unsigned long long)wave_or(mk.w) << 32);
        LAS float* stg = (LAS float*)(L + OFF_STG + w * 8192);
        __syncthreads();
        int it = 0;
        {
            f32x16 o[2] = {f32x16{}, f32x16{}}; f32x16 lacc = f32x16{};
            sw8_branch<0>(o, lacc, L, it, (const bf16*)(p.ws + WS_KS) + (size_t)bh * T_ * 64, (const bf16*)(p.ws + WS_VS) + (size_t)bh * T_ * 64, qf, mlo, mhi, cur, tq, -M2s, w, lane, r32, hi, wlo, whi);
            LDS_FENCE(); if (hi == 0) wsf[r32] = GATES[(size_t)m * 24 + hk * 12 + g * 3 + 1]; LDS_FENCE();
            __syncthreads();
#pragma unroll
            for (int r = 0; r < 16; ++r) { const int q = crow(r, hi); const float fr = wsf[q] * __builtin_amdgcn_rcpf(fmaxf(lacc[r], 1e-30f)); stg[q * 64 + r32] = fr * o[0][r]; stg[q * 64 + 32 + r32] = fr * o[1][r]; }
        }
        {
            f32x16 o[2] = {f32x16{}, f32x16{}}; f32x16 lacc = f32x16{};
            int itw = 0;
            sw6_branch<1, false>(o, lacc, L, itw, (const bf16*)(p.ws + WS_KW) + (size_t)bh * T_ * 64, (const bf16*)(p.ws + WS_VW) + (size_t)bh * T_ * 64, qf, mlo, mhi, cur, tq, -M2w, w, lane, r32, hi, 0ull, 0ull);
            LDS_FENCE(); if (hi == 0) wsf[r32] = GATES[(size_t)m * 24 + hk * 12 + g * 3 + 2]; LDS_FENCE();
#pragma unroll
            for (int r = 0; r < 16; ++r) { const int q = crow(r, hi); const float fr = wsf[q] * __builtin_amdgcn_rcpf(fmaxf(lacc[r], 1e-30f)); stg[q * 64 + r32] += fr * o[0][r]; stg[q * 64 + 32 + r32] += fr * o[1][r]; }
        }
        {
            LDS_FENCE();
#pragma unroll
            for (int k = 0; k < 4; ++k) {
                const int q = 8 * k + (lane >> 3), ch = lane & 7;
                const size_t mo = (size_t)(b * T_ + t0 + 8 * w + (q >> 2)); const int col = hk * 256 + (q & 3) * 64 + ch * 8;
                const f32x4v a0 = *(LAS const f32x4v*)(stg + q * 64 + ch * 8), a1 = *(LAS const f32x4v*)(stg + q * 64 + ch * 8 + 4);
                const v4u oc = *(const v4u*)(OCB + mo * 512 + col);
                v4u ov;
                ov.x = cvtpk(a0[0] + bf2f((bf16)(oc.x & 0xffffu)), a0[1] + bf2f((bf16)(oc.x >> 16)));
                ov.y = cvtpk(a0[2] + bf2f((bf16)(oc.y & 0xffffu)), a0[3] + bf2f((bf16)(oc.y >> 16)));
                ov.z = cvtpk(a1[0] + bf2f((bf16)(oc.z & 0xffffu)), a1[1] + bf2f((bf16)(oc.z >> 16)));
                ov.w = cvtpk(a1[2] + bf2f((bf16)(oc.w & 0xffffu)), a1[3] + bf2f((bf16)(oc.w >> 16)));
                *(v4u*)(MIX + mo * D_ + col) = ov;
            }
            LDS_FENCE();
        }
    }
}


#define LDS3 ((LAS unsigned char*)lds)
__device__ __forceinline__ void ph_gemm_gu(float* lds, const bf16* XN, const bf16* Wgu, bf16* ACT, const float* rowsq) {
    pg8::Gemm g{XN, Wgu, NT, 2 * FF, D_, D_}; pg8::StaticOrder S; S.init(NT, 2 * FF, gridDim.x, blockIdx.x);
    pg8::EpiSwiglu E{ACT, FF, rowsq};
    pg8::gemm_phase<pg8::EpiSwiglu, pg8::StaticOrder, true, true>(LDS3, g, S, E);
}
template <bool NORM, int RS, bool HALFSTEP, bool BASEBF, bool OUTF32>
__device__ __forceinline__ void ph_gemm_resid(float* lds, const bf16* A, const bf16* Bt, int K, const float* base, float* out, unsigned char* ws, const float* g1 = nullptr) {
    pg8::Gemm g{A, Bt, NT, D_, K, K}; pg8::StaticOrder S; S.init(NT, D_, gridDim.x, blockIdx.x);
    pg8::EpiResid<NORM, RS, HALFSTEP, BASEBF, OUTF32> E{base, out, ws, g1};
    pg8::gemm_phase<pg8::EpiResid<NORM, RS, HALFSTEP, BASEBF, OUTF32>, pg8::StaticOrder, true, true>(LDS3, g, S, E);
}
__device__ __forceinline__ void ph_gemm_win(const Params& p, float* lds) {
    pg8::Gemm g{(const bf16*)(p.ws + WS_XN), (const bf16*)(p.ws + WS_WIN), NT, INP, D_, D_}; pg8::StaticOrder S; S.init(NT, INP, gridDim.x, blockIdx.x);
    pg8::EpiWin E{p.ws, (const float*)(p.ws + WS_ROWSQ)};
    pg8::gemm_phase<pg8::EpiWin, pg8::StaticOrder, true, true>(LDS3, g, S, E);
}
__device__ __forceinline__ void cmp2_panel(const Params& p, int kv, int pm) {
    using namespace fa;
    const int tid = tid_(), lane = tid & 63, w = __builtin_amdgcn_readfirstlane(tid >> 6), r32 = lane & 31, hi = lane >> 5;
    const int row = 256 * pm + 32 * w + r32;
    const bf16* hrow = (const bf16*)(p.ws + WS_HC) + ((size_t)kv * 4096 + row) * 256;
    const bf16* w2t = (const bf16*)(p.ws + WS_W2T) + (size_t)kv * 64 * 256;
    f32x16 acc[2] = {f32x16{}, f32x16{}};
#pragma unroll 4
    for (int ks = 0; ks < 16; ++ks) {
        const bf16x8 hb = *(const bf16x8*)(hrow + 16 * ks + 8 * hi);
#pragma unroll
        for (int blk = 0; blk < 2; ++blk) { const bf16x8 wa = *(const bf16x8*)(w2t + (size_t)(32 * blk + r32) * 256 + 16 * ks + 8 * hi);
            acc[blk] = __builtin_amdgcn_mfma_f32_32x32x16_bf16(wa, hb, acc[blk], 0, 0, 0); }
    }
    const int bh = row >> 9, n = row & 511, b = bh >> 1;
    if (n >= NCMP) return;
    if (kv) {
        bf16* dst = (bf16*)(p.ws + WS_VCB) + ((size_t)bh * 512 + n) * 64;
#pragma unroll
        for (int blk = 0; blk < 2; ++blk)
#pragma unroll
            for (int rq = 0; rq < 4; ++rq) { v2u q; q.x = cvtpk(acc[blk][4 * rq], acc[blk][4 * rq + 1]); q.y = cvtpk(acc[blk][4 * rq + 2], acc[blk][4 * rq + 3]); *(v2u*)(dst + 32 * blk + 8 * rq + 4 * hi) = q; }
        return;
    }
    float ss = 0.f;
#pragma unroll
    for (int blk = 0; blk < 2; ++blk)
#pragma unroll
        for (int r = 0; r < 16; ++r) ss += acc[blk][r] * acc[blk][r];
    ss += shx<32>(ss);
    const float rr = rsqrtf(ss * (1.f / 64.f) + EPS);
    const float* g = p.in[10];
#pragma unroll
    for (int blk = 0; blk < 2; ++blk)
#pragma unroll
        for (int rq = 0; rq < 4; ++rq) { const f32x4v gg = *(const f32x4v*)(g + 32 * blk + 8 * rq + 4 * hi);
#pragma unroll
            for (int i = 0; i < 4; ++i) acc[blk][4 * rq + i] *= rr * gg[i]; }
    {
        const int m = b * T_ + 16 * n + 31;
        const f32x4v c4 = *(const f32x4v*)((const float*)(p.ws + WS_ROPEC) + (size_t)m * 8 + 4 * hi), s4 = *(const f32x4v*)((const float*)(p.ws + WS_ROPES) + (size_t)m * 8 + 4 * hi);
#pragma unroll
        for (int i = 0; i < 4; ++i) { const float y0 = acc[0][i], y1 = acc[0][4 + i]; acc[0][i] = y0 * c4[i] - y1 * s4[i]; acc[0][4 + i] = y1 * c4[i] + y0 * s4[i]; }
    }
    bf16* dst = (bf16*)(p.ws + WS_KCB) + ((size_t)bh * 512 + n) * 64;
#pragma unroll
    for (int blk = 0; blk < 2; ++blk)
#pragma unroll
        for (int rq = 0; rq < 4; ++rq) { v2u q; q.x = cvtpk(acc[blk][4 * rq], acc[blk][4 * rq + 1]); q.y = cvtpk(acc[blk][4 * rq + 2], acc[blk][4 * rq + 3]); *(v2u*)(dst + 32 * blk + 8 * rq + 4 * hi) = q; }
}
__device__ __forceinline__ void ph_gemm_cmp1(const Params& p, float* lds) {
    float* biasw = (float*)(p.ws + WS_BIASW) + (size_t)(blockIdx.x & 31) * 256;
    if (blockIdx.x < 32) {
        const int j = tid_();
        if (j < 256) { const float* part = (const float*)(p.ws + WS_BIASP) + (blockIdx.x >= 16 ? 256 : 0) + j; float a = 0.f;
#pragma unroll
            for (int b = 0; b < 64; ++b) a += part[b * 512];
            biasw[j] = a; }
        asm volatile("s_waitcnt vmcnt(0)" ::: "memory"); __syncthreads();
    }
    {   pg8::Gemm g{(const bf16*)(p.ws + WS_KCR), (const bf16*)(p.ws + WS_WC1K), 4096, 256, 2048, 1024}; pg8::OffsetOrder S{(int)blockIdx.x, 0, 16, 1};
        pg8::EpiCmp1 E{(bf16*)(p.ws + WS_HC), biasw};
        pg8::gemm_phase<pg8::EpiCmp1, pg8::OffsetOrder, true, true>(LDS3, g, S, E);
        if ((int)blockIdx.x < 16) { __syncthreads(); cmp2_panel(p, 0, (int)blockIdx.x); } }
    {   pg8::Gemm g{(const bf16*)(p.ws + WS_VCR), (const bf16*)(p.ws + WS_WC1V), 4096, 256, 2048, 1024}; pg8::OffsetOrder S{(int)blockIdx.x, 16, 16, 1};
        pg8::EpiCmp1 E{(bf16*)(p.ws + WS_HC) + (size_t)4096 * 256, biasw};
        pg8::gemm_phase<pg8::EpiCmp1, pg8::OffsetOrder, true, true>(LDS3, g, S, E);
        if ((int)blockIdx.x >= 16 && (int)blockIdx.x < 32) { __syncthreads(); cmp2_panel(p, 1, (int)blockIdx.x - 16); } }
}
__device__ __forceinline__ void ph_gemm_memq(const Params& p, float* lds) {
    {   pg8::Gemm g{(const bf16*)(p.ws + WS_XN), (const bf16*)(p.ws + WS_WMQ), NT, 256, D_, D_}; pg8::StaticOrder S; S.init(NT, 256, gridDim.x, blockIdx.x);
        pg8::EpiHeadNorm E{(bf16*)(p.ws + WS_QMEM), nullptr, p.in[25], Q_SCALE, (const float*)(p.ws + WS_ROWSQ) + NT};
        pg8::gemm_phase<pg8::EpiHeadNorm, pg8::StaticOrder, true, true>(LDS3, g, S, E); }
    {   pg8::Gemm g{(const bf16*)(p.ws + WS_XN) + (size_t)NT * D_, (const bf16*)(p.ws + WS_WMKV), NMEM, 512, D_, D_}; pg8::OffsetOrder S{(int)blockIdx.x, 128, 4, 2};
        pg8::EpiHeadNorm E{(bf16*)(p.ws + WS_KMEM), (bf16*)(p.ws + WS_VMEM), p.in[26], 1.0f, nullptr};
        pg8::gemm_phase<pg8::EpiHeadNorm, pg8::OffsetOrder, true, true>(LDS3, g, S, E); }
}

#ifndef PROBE_ABL
#define PROBE_ABL 2
#endif
constexpr int NPH = 19;
__device__ __forceinline__ void run_phase(const Params& p, float* lds, int ph) {
    unsigned char* ws = p.ws;
    switch (ph) {
    case 0: ph_prologue(p, LDS3); break;
    case 1: ph_gemm_gu(lds, (const bf16*)(ws + WS_XN), (const bf16*)(ws + WS_WGU1), (bf16*)(ws + WS_ACT), nullptr); break;
    case 2: ph_gemm_resid<true, 0, true, false, false>(lds, (const bf16*)(ws + WS_ACT), (const bf16*)(ws + WS_WD1), FF, p.in[0], p.out, ws, p.in[3]); break;
    case 4: ph_gemm_win(p, lds); break;
    case 5: ph_gemm_cmp1(p, lds); ph_sb_fast(p, lds); break;
    case 7: ph_nsa_cmp_fast<0>(p, lds); break;
    case 8: ph_nsa_selwin6(p, lds); break;
    case 11: ph_gemm_resid<true, 1, false, true, false>(lds, (const bf16*)(ws + WS_MIX), (const bf16*)(ws + WS_WOUT), D_, p.out, p.out, ws); break;
    case 13: ph_gemm_memq(p, lds); break;
    case 14: ph_memattn_fast(p, lds); break;
    case 15: ph_gemm_resid<true, 2, false, true, false>(lds, (const bf16*)(ws + WS_OMEM), (const bf16*)(ws + WS_WMO), 256, p.out, p.out, ws); break;
    case 17: ph_gemm_gu(lds, (const bf16*)(ws + WS_XN), (const bf16*)(ws + WS_WGU2), (bf16*)(ws + WS_ACT), (const float*)(ws + WS_ROWSQ) + 2 * NT); break;
    case 18: ph_gemm_resid<false, 0, true, true, true>(lds, (const bf16*)(ws + WS_ACT), (const bf16*)(ws + WS_WD2), FF, p.out, p.out, ws); break;
    default: break;
    }
}
#ifndef PROBE_MASK
#define PROBE_MASK 0u
#endif
typedef const __attribute__((address_space(4))) Params* KargPtr;
#if defined(__HIP_DEVICE_COMPILE__)
#define PHASE(i) do { KargPtr pp = (KargPtr)__builtin_amdgcn_kernarg_segment_ptr(); asm volatile("" : "+s"(pp)); Params q; _Pragma("unroll") for (int k_ = 0; k_ < 32; ++k_) q.in[k_] = pp->in[k_]; q.pos = pp->pos; q.out = pp->out; q.ws = pp->ws; run_phase(q, lds, i); } while (0)
#else
#define PHASE(i) do { run_phase(p, lds, i); } while (0)
#endif
constexpr int LDS_BYTES = 163840, LDS_BARST = LDS_BYTES - 64;
__global__ void __launch_bounds__(NTHR, 2) mega(Params p) {
    extern __shared__ __attribute__((aligned(16))) float lds[];
    volatile LAS unsigned* barst = (volatile LAS unsigned*)((LAS unsigned char*)lds + LDS_BARST);
    if (tid_() < 16) barst[tid_()] = 0u;
    __syncthreads();
    XcdBarrier bar = xcd_barrier_post((unsigned*)(p.ws + WS_CTL), barst);
    if (tid_() == 0) {
        unsigned* ctl = (unsigned*)(p.ws + WS_CTL); const unsigned x = xb_xcc_id() & 7u;
        const unsigned rank = __hip_atomic_fetch_add(ctl + CW_XRANK + 64 * x, 1u, __ATOMIC_RELAXED, __HIP_MEMORY_SCOPE_AGENT);
        if (blockIdx.x < 256) __hip_atomic_store(ctl + CW_VCU + blockIdx.x, x * 32u + (rank & 31u), __ATOMIC_RELAXED, __HIP_MEMORY_SCOPE_AGENT);
    }
#define SEAM() xcd_barrier(bar)
    if (p.ws == nullptr) __builtin_amdgcn_s_sleep(1);
    PHASE(0); SEAM();
    PHASE(1); SEAM();
    PHASE(2); SEAM();
    PHASE(4); SEAM();
    PHASE(5); SEAM();
    PHASE(7);
    asm volatile("s_waitcnt vmcnt(0)" ::: "memory"); __syncthreads();
    PHASE(8); SEAM();
    PHASE(11); SEAM();
    PHASE(13); SEAM();
    PHASE(14); SEAM();
    PHASE(15); SEAM();
    PHASE(17); SEAM();
    PHASE(18);
#undef SEAM
}

extern "C" void kernel_launch(void* const* d_in, const int* in_sizes, int n_in, void* d_out, int out_size, void* d_ws, size_t ws_size, hipStream_t stream) {
    if (n_in != 32 || ws_size < WS_NEED) { fprintf(stderr, "kernel_launch: unexpected n_in %d or ws_size %zu (need %zu)\n", n_in, ws_size, (size_t)WS_NEED); return; }
    Params p{};
    for (int i = 0; i < 32; ++i) p.in[i] = (const float*)d_in[i];
    p.pos = (const int*)d_in[2]; p.out = (float*)d_out; p.ws = (unsigned char*)d_ws;
    static int grid_blocks = 0;
    if (!grid_blocks) {
        int dev = 0, cus = 0, per_cu = 0;
        (void)hipGetDevice(&dev);
        (void)hipDeviceGetAttribute(&cus, hipDeviceAttributeMultiprocessorCount, dev);
        (void)hipFuncSetAttribute((const void*)mega, hipFuncAttributeMaxDynamicSharedMemorySize, LDS_BYTES);
        (void)hipOccupancyMaxActiveBlocksPerMultiprocessor(&per_cu, (const void*)mega, NTHR, LDS_BYTES);
        if (per_cu < 1) per_cu = 1;
        grid_blocks = cus * per_cu;
    }
    (void)hipMemsetAsync((char*)d_ws + WS_CTL, 0, 65536, stream);
    void* args[] = {&p};
    hipError_t e = hipLaunchCooperativeKernel((const void*)mega, dim3(grid_blocks), dim3(NTHR), args, LDS_BYTES, stream);
    if (e != hipSuccess) fprintf(stderr, "cooperative launch failed: %s (grid %d)\n", hipGetErrorString(e), grid_blocks);
}
```

```cpp
#include <hip/hip_runtime.h>
#include <hip/hip_cooperative_groups.h>
#include <cstdio>
#include <cstdint>
#include <cmath>
namespace cg = cooperative_groups;

constexpr int B_ = 4, T_ = 8192, D_ = 1024, NT = B_ * T_;
constexpr int MEM_ = 256, NMEM = B_ * MEM_;
constexpr int FF = 2816, INC = 2840, INP = 3072;
constexpr int NCMP = 511;
constexpr float EPS = 1e-6f;
constexpr float Q_SCALE = 0.125f * 1.4426950408889634f;
constexpr int NTHR = 512, NWV = 8;
constexpr int C_QN = 0, C_KC = 512, C_VC = 640, C_KS = 768, C_VS = 896, C_KW = 1024, C_VW = 1152, C_GT = 1280, C_QS = 1304, C_KSB = 1816, C_VSB = 2328;

constexpr size_t MiB = (size_t)1 << 20;
constexpr size_t WS_CTL = 0;
constexpr size_t WS_WGU1 = 1 * MiB, WS_WD1 = 12 * MiB, WS_WGU2 = 18 * MiB, WS_WD2 = 29 * MiB;
constexpr size_t WS_WIN = 35 * MiB, WS_WOUT = 41 * MiB, WS_WMQ = 43 * MiB, WS_WMKV = 43 * MiB + MiB / 2, WS_WMO = 44 * MiB + MiB / 2;
constexpr size_t WS_WC1K = 45 * MiB, WS_WC1V = 46 * MiB;
constexpr size_t WS_ROPEC = 47 * MiB, WS_ROPES = 48 * MiB;
constexpr size_t WS_GATES = 49 * MiB;
constexpr size_t WS_IDX = 52 * MiB;
constexpr size_t WS_SELM = 64 * MiB;
constexpr size_t WS_KC = 56 * MiB, WS_VC = 57 * MiB;
constexpr size_t WS_KCB = 52 * MiB, WS_VCB = 52 * MiB + MiB / 2;
constexpr size_t WS_HC = 58 * MiB;
constexpr size_t WS_KMEM = 62 * MiB, WS_VMEM = 62 * MiB + MiB / 2;
constexpr size_t WS_W2T = 63 * MiB + 960 * 1024;
constexpr size_t WS_BIASW = 63 * MiB + 896 * 1024;
constexpr size_t WS_BIASC = 63 * MiB;
constexpr size_t WS_GTAB = 63 * MiB + 4096;
constexpr size_t WS_GMAX = 63 * MiB + 4096 + 1024;
constexpr size_t WS_RMS1 = 63 * MiB + 768 * 1024;
constexpr size_t WS_BIASP = 63 * MiB + 512 * 1024;
constexpr size_t WS_ROWSQ = 63 * MiB + 65536;
constexpr size_t WS_XN = 65 * MiB;
constexpr size_t WS_ACT = 131 * MiB;
constexpr size_t WS_QN = 131 * MiB;
constexpr size_t WS_KS = 163 * MiB, WS_VS = 171 * MiB, WS_KW = 179 * MiB, WS_VW = 187 * MiB, WS_KCR = 195 * MiB, WS_VCR = 203 * MiB;
constexpr size_t WS_QS = 212 * MiB;
constexpr size_t WS_KSB = 244 * MiB, WS_VSB = 276 * MiB;
constexpr size_t WS_MIX = 308 * MiB;
constexpr size_t WS_QMEM = 372 * MiB, WS_OMEM = 388 * MiB;
constexpr size_t WS_OCB = 404 * MiB, WS_OSB = 436 * MiB;
constexpr size_t WS_NEED = 468 * MiB;

constexpr int CW_XRANK = 4096, CW_VCU = 8192, CW_SBQ = 12288;
struct Params {
    const float* in[32];
    const int* pos;
    float* out;
    unsigned char* ws;
};

#define GAS __attribute__((address_space(1)))
#define LAS __attribute__((address_space(3)))
typedef unsigned short bf16;
typedef unsigned v4u __attribute__((ext_vector_type(4)));
typedef unsigned v2u __attribute__((ext_vector_type(2)));
__device__ __forceinline__ int tid_() { int t = threadIdx.x; asm volatile("" : "+v"(t)); return t; }
template <int K> __device__ __forceinline__ float shx(float v) {
    if constexpr (K == 32) {
        const unsigned u = __builtin_bit_cast(unsigned, v); auto r = __builtin_amdgcn_permlane32_swap(u, u, false, false);
        return __builtin_bit_cast(float, (unsigned)((__builtin_amdgcn_mbcnt_hi(~0u, __builtin_amdgcn_mbcnt_lo(~0u, 0u)) >= 32u) ? r[0] : r[1]));
    } else if constexpr (K == 1) return __builtin_bit_cast(float, __builtin_amdgcn_mov_dpp(__builtin_bit_cast(int, v), 0xB1, 0xf, 0xf, true));
    else if constexpr (K == 2) return __builtin_bit_cast(float, __builtin_amdgcn_mov_dpp(__builtin_bit_cast(int, v), 0x4E, 0xf, 0xf, true));
    else return __builtin_bit_cast(float, __builtin_amdgcn_ds_swizzle(__builtin_bit_cast(int, v), (K << 10) | 0x1f));
}
template <int K> __device__ __forceinline__ int shxi(int v) { return __builtin_bit_cast(int, shx<K>(__builtin_bit_cast(float, v))); }
__device__ __forceinline__ float wave_sum(float v) { v += shx<1>(v); v += shx<2>(v); v += shx<4>(v); v += shx<8>(v); v += shx<16>(v); v += shx<32>(v); return v; }
__device__ __forceinline__ float wave_max(float v) { v = fmaxf(v, shx<1>(v)); v = fmaxf(v, shx<2>(v)); v = fmaxf(v, shx<4>(v)); v = fmaxf(v, shx<8>(v)); v = fmaxf(v, shx<16>(v)); v = fmaxf(v, shx<32>(v)); return v; }
#define LDS_FENCE() do { asm volatile("s_waitcnt lgkmcnt(0)" ::: "memory"); __builtin_amdgcn_wave_barrier(); } while (0)
__device__ __forceinline__ unsigned f2bf(float f) { unsigned u = __builtin_bit_cast(unsigned, f); return (u + 0x7fffu + ((u >> 16) & 1u)) >> 16; }
__device__ __forceinline__ unsigned pk2(float lo, float hi) { return f2bf(lo) | (f2bf(hi) << 16); }
__device__ __forceinline__ float bf2f(bf16 v) { return __builtin_bit_cast(float, (unsigned)v << 16); }

__device__ __forceinline__ void sincos_acc(float ang, float& s, float& c) {
    const double a = (double)ang;
    const double k = rint(a * 0.63661977236758134308);
    const double r = fma(-k, 1.57079632679489661923, a) - k * 6.123233995736766e-17;
    const double r2 = r * r;
    double sp = r * (1.0 + r2 * (-1.0 / 6 + r2 * (1.0 / 120 + r2 * (-1.0 / 5040 + r2 * (1.0 / 362880 + r2 * (-1.0 / 39916800 + r2 * (1.0 / 6227020800.0)))))));
    double cp = 1.0 + r2 * (-0.5 + r2 * (1.0 / 24 + r2 * (-1.0 / 720 + r2 * (1.0 / 40320 + r2 * (-1.0 / 3628800 + r2 * (1.0 / 479001600.0 + r2 * (-1.0 / 87178291200.0)))))));
    const int q = ((int)k) & 3;
    double ss = (q & 1) ? cp : sp, cc = (q & 1) ? sp : cp;
    if (q == 1) cc = -cc; else if (q == 2) { ss = -ss; cc = -cc; } else if (q == 3) ss = -ss;
    s = (float)ss; c = (float)cc;
}
__device__ __forceinline__ float gelu_tanh(float x) { return 0.5f * x * (1.0f + tanhf(0.7978845608028654f * (x + 0.044715f * x * x * x))); }
__device__ __forceinline__ float sigmoidf_(float x) { return 1.0f / (1.0f + expf(-x)); }
__device__ __forceinline__ float softplusf_(float z) { return fmaxf(z, 0.f) + log1pf(expf(-fabsf(z))); }
__constant__ float ROPE_FREQ[8] = {1.0f, 0.19392274f, 0.03760603f, 0.0072926646f, 0.0014142136f, 0.0002742482f, 5.3182957e-05f, 1.0313385e-05f};

__host__ __device__ __forceinline__ int colmap_rope(int wc, int d) {
    if (d < 16) { const int i = d & 7, half = d >> 3; return 32 * wc + 8 * (i >> 1) + 2 * half + (i & 1); }
    if (d < 32) return 32 * wc + 8 * ((d - 16) >> 2) + 4 + ((d - 16) & 3);
    return 128 + 32 * wc + (d - 32);
}
__host__ __device__ __forceinline__ int colmap_head(int wc, int d) { return d < 32 ? 32 * wc + d : 128 + 32 * wc + (d - 32); }
namespace pg8 {
#define PG8_LAS __attribute__((address_space(3)))
typedef unsigned short bf16_t;
typedef short bf16x8 __attribute__((ext_vector_type(8)));
typedef float f32x4 __attribute__((ext_vector_type(4)));
typedef unsigned u32x4 __attribute__((ext_vector_type(4)));
constexpr int BM = 256, BK = 64, HALF = 128, HTB = HALF * BK * 2  , STAGE_BYTES = 8 * HTB, NXCD = 8, WGM = 8;

__host__ __device__ __forceinline__ int lds_byte(int r, int c) { const int st = (r >> 4) * 2 + (c >> 5), rr = r & 15, cc = c & 31, ob = rr * 64 + cc * 2; return st * 1024 + (ob ^ (((ob >> 9) & 1) << 5)); }
__host__ __device__ __forceinline__ void stage_rc(int b, int& R, int& C) { const int st = b / 1024, sb = b % 1024, swz = sb ^ (((sb >> 9) & 1) << 5); R = (st >> 1) * 16 + swz / 64; C = (st & 1) * 32 + (swz % 64) / 2; }
__host__ __device__ __forceinline__ int perm32(int rho) { const int n = rho >> 4, i = rho & 15; return 8 * (i >> 2) + 4 * n + (i & 3); }

struct Unit { int pm, pn; };
struct Gemm { const bf16_t* A; const bf16_t* Bt; int M, N, K, lda; };

struct StaticOrder {
    int nM, nN, nwg, G, c;
    __host__ __device__ void init(int M, int N, int G_, int c_) { nM = M / BM; nN = N / BM; nwg = nM * nN; G = G_; c = c_; }
    __host__ __device__ bool next(int i, Unit& u) const {
        const long L = (long)i * G + c; if (L >= nwg) return false;
        int wgid = (int)L; { const int q = nwg / NXCD, r = nwg % NXCD, xcd = wgid % NXCD, off = wgid / NXCD; wgid = (xcd < r ? xcd * (q + 1) : r * (q + 1) + (xcd - r) * q) + off; }
        const int nig = WGM * nN, gid = wgid / nig, fm = gid * WGM, gsz = (nM - fm) < WGM ? (nM - fm) : WGM;
        u.pm = fm + ((wgid % nig) % gsz); u.pn = (wgid % nig) / gsz; return true;
    }
    __device__ __forceinline__ void a_ready(const Unit&) const {}
    __device__ __forceinline__ void done(const Unit&) const {}
};


__device__ __forceinline__ unsigned cvt_pk_bf16(float lo, float hi) { unsigned r; asm volatile("v_cvt_pk_bf16_f32 %0, %1, %2" : "=v"(r) : "v"(lo), "v"(hi)); return r; }
template <class Epi, class Sched, bool ALIGN_EPI = false, bool SP2 = false>
__device__ __forceinline__ void gemm_phase(PG8_LAS unsigned char* lds, const Gemm g, const Sched& S, const Epi& E) {
    const int tid = tid_(), wid = __builtin_amdgcn_readfirstlane(tid >> 6), lane = tid & 63, wr = wid >> 2, wc = wid & 3, fr = lane & 15, fq = lane >> 4;
    const int K = g.K, nt = K / BK;
    unsigned voffA[2], voffB[2];
#pragma unroll
    for (int i = 0; i < 2; ++i) { int R, C; stage_rc(tid * 16 + i * 8192, R, C); const int Rb = Epi::PERM ? ((R & ~31) + perm32(R & 31)) : R;
        voffA[i] = (unsigned)(R * g.lda + C) * 2u; voffB[i] = (unsigned)(Rb * K + C) * 2u; }
    const size_t kstep = (size_t)(BK * 2);
    const size_t hstep = (size_t)HALF * K * 2;
    const size_t tstep = 2 * hstep;
    const size_t hstepA = (size_t)HALF * g.lda * 2, tstepA = 2 * hstepA;
    const unsigned ldsw = (unsigned)wid * 1024u;
    const int aoff = lds_byte(wr * 64 + fr, fq * 8), boff = lds_byte(wc * 32 + fr, fq * 8);
#define PG8_SA(b, h) (((b) * 2 + (h)) * HTB)
#define PG8_SB(b, h) ((4 + (b) * 2 + (h)) * HTB)
#define PG8_STAGE(bufoff, gbase, voff) do { _Pragma("unroll") for (int _i = 0; _i < 2; ++_i) \
        __builtin_amdgcn_global_load_lds((const unsigned*)((const char*)(gbase) + (voff)[_i]), (PG8_LAS unsigned*)(lds + (bufoff) + ldsw + _i * 8192), 16, 0, 0); } while (0)
#define PG8_LDA(dst, b, h) do { _Pragma("unroll") for (int m = 0; m < 4; ++m) _Pragma("unroll") for (int k = 0; k < 2; ++k) dst[m][k] = *(const PG8_LAS bf16x8*)(lds + PG8_SA(b, h) + aoff + m * 2048 + k * 1024); } while (0)
#define PG8_LDB(dst, b, h) do { _Pragma("unroll") for (int n = 0; n < 2; ++n) _Pragma("unroll") for (int k = 0; k < 2; ++k) dst[n][k] = *(const PG8_LAS bf16x8*)(lds + PG8_SB(b, h) + boff + n * 2048 + k * 1024); } while (0)
#define PG8_MMA(ai, bj, At, Bt) do { __builtin_amdgcn_s_setprio(1); _Pragma("unroll") for (int m = 0; m < 4; ++m) _Pragma("unroll") for (int n = 0; n < 2; ++n) _Pragma("unroll") for (int k = 0; k < 2; ++k) \
        acc[ai][bj][m][n] = __builtin_amdgcn_mfma_f32_16x16x32_bf16(Bt[n][k], At[m][k], acc[ai][bj][m][n], 0, 0, 0); __builtin_amdgcn_s_setprio(0); } while (0)
#define PG8_WAIT_V(n) asm volatile("s_waitcnt vmcnt(" #n ")" ::: "memory")
#define PG8_WAIT_L(n) asm volatile("s_waitcnt lgkmcnt(" #n ")" ::: "memory")
#define PG8_BAR __builtin_amdgcn_s_barrier()
#define PG8_SCHED __builtin_amdgcn_sched_barrier(0)
    Unit cur, nxt; int ui = 0;
    if (!S.next(0, cur)) return;
    f32x4 acc[2][2][4][2];
#pragma unroll
    for (int a = 0; a < 2; ++a)
#pragma unroll
        for (int b = 0; b < 2; ++b)
#pragma unroll
            for (int m = 0; m < 4; ++m)
#pragma unroll
                for (int n = 0; n < 2; ++n) acc[a][b][m][n] = (f32x4){0.f, 0.f, 0.f, 0.f};
    bf16x8 At[4][2], B0[2][2], B1[2][2];
    const char* cA = (const char*)g.A + (size_t)cur.pm * tstepA; const char* cB = (const char*)g.Bt + (size_t)cur.pn * tstep;
    S.a_ready(cur);
    if constexpr (SP2) {
        PG8_STAGE(PG8_SB(0, 0), cB, voffB); PG8_STAGE(PG8_SB(0, 1), cB + hstep, voffB); PG8_STAGE(PG8_SA(0, 0), cA, voffA); PG8_STAGE(PG8_SA(0, 1), cA + hstepA, voffA);
        if (wr == 1) PG8_BAR;
        PG8_WAIT_V(2); PG8_BAR;
        PG8_STAGE(PG8_SB(1, 0), cB + kstep, voffB); PG8_STAGE(PG8_SA(1, 0), cA + kstep, voffA); PG8_STAGE(PG8_SB(1, 1), cB + hstep + kstep, voffB);
        PG8_WAIT_V(6); PG8_BAR;
    } else {
        PG8_STAGE(PG8_SB(0, 0), cB, voffB); PG8_STAGE(PG8_SA(0, 0), cA, voffA); PG8_STAGE(PG8_SB(0, 1), cB + hstep, voffB); PG8_STAGE(PG8_SA(0, 1), cA + hstepA, voffA);
        if (wr == 1) PG8_BAR;
        PG8_WAIT_V(4); PG8_BAR;
        PG8_STAGE(PG8_SB(1, 0), cB + kstep, voffB); PG8_STAGE(PG8_SA(1, 0), cA + kstep, voffA); PG8_STAGE(PG8_SB(1, 1), cB + hstep + kstep, voffB);
        PG8_WAIT_V(6); PG8_BAR;
    }
    for (;;) {
        const bool has_next = S.next(ui + 1, nxt);
        const char* nA = has_next ? (const char*)g.A + (size_t)nxt.pm * tstepA : cA; const char* nB = has_next ? (const char*)g.Bt + (size_t)nxt.pn * tstep : cB;
        for (int t = 0; t < nt; t += 2) {
            const bool last = (t == nt - 2);
            const char* a1 = cA + (size_t)(t + 1) * kstep;
            const char* a2 = last ? nA : cA + (size_t)(t + 2) * kstep; const char* b2 = last ? nB : cB + (size_t)(t + 2) * kstep;
            const char* a3 = a2 + kstep; const char* b3 = b2 + kstep;
            if (last && has_next) S.a_ready(nxt);
            if constexpr (SP2) {
            PG8_LDB(B0, 0, 0); PG8_LDB(B1, 0, 1); PG8_SCHED; PG8_LDA(At, 0, 0); PG8_STAGE(PG8_SA(1, 1), a1 + hstepA, voffA);
            PG8_WAIT_V(8); PG8_WAIT_L(0); PG8_BAR; PG8_MMA(0, 0, At, B0); PG8_MMA(0, 1, At, B1); PG8_BAR; PG8_SCHED;
            PG8_LDA(At, 0, 1); PG8_STAGE(PG8_SB(0, 0), b2, voffB); PG8_STAGE(PG8_SB(0, 1), b2 + hstep, voffB); PG8_STAGE(PG8_SA(0, 0), a2, voffA);
            PG8_WAIT_V(8); PG8_WAIT_L(0); PG8_BAR; PG8_MMA(1, 0, At, B0); PG8_MMA(1, 1, At, B1); PG8_BAR; PG8_SCHED;
            PG8_LDB(B0, 1, 0); PG8_LDB(B1, 1, 1); PG8_SCHED; PG8_LDA(At, 1, 0); PG8_STAGE(PG8_SA(0, 1), a2 + hstepA, voffA);
            PG8_WAIT_V(8); PG8_WAIT_L(0); PG8_BAR; PG8_MMA(0, 0, At, B0); PG8_MMA(0, 1, At, B1); PG8_BAR; PG8_SCHED;
            PG8_LDA(At, 1, 1); PG8_STAGE(PG8_SB(1, 0), b3, voffB); PG8_STAGE(PG8_SB(1, 1), b3 + hstep, voffB); PG8_STAGE(PG8_SA(1, 0), a3, voffA);
            PG8_WAIT_V(8); PG8_WAIT_L(0); PG8_BAR; PG8_MMA(1, 0, At, B0); PG8_MMA(1, 1, At, B1); PG8_BAR; PG8_SCHED;
            } else {
            PG8_LDB(B0, 0, 0); PG8_SCHED; PG8_LDA(At, 0, 0); PG8_STAGE(PG8_SA(1, 1), a1 + hstepA, voffA);
            PG8_WAIT_L(8); PG8_BAR; PG8_WAIT_L(0); PG8_MMA(0, 0, At, B0); PG8_BAR; PG8_SCHED;
            PG8_LDB(B1, 0, 1); PG8_STAGE(PG8_SB(0, 0), b2, voffB);
            PG8_BAR; PG8_WAIT_L(0); PG8_MMA(0, 1, At, B1); PG8_BAR;
            PG8_LDA(At, 0, 1); PG8_STAGE(PG8_SA(0, 0), a2, voffA);
            PG8_BAR; PG8_WAIT_L(0); PG8_MMA(1, 0, At, B0); PG8_BAR; PG8_SCHED;
            PG8_STAGE(PG8_SB(0, 1), b2 + hstep, voffB);
            PG8_WAIT_V(6); PG8_BAR; PG8_MMA(1, 1, At, B1); PG8_BAR;
            PG8_LDB(B0, 1, 0); PG8_SCHED; PG8_LDA(At, 1, 0); PG8_STAGE(PG8_SA(0, 1), a2 + hstepA, voffA);
            PG8_WAIT_L(8); PG8_BAR; PG8_WAIT_L(0); PG8_MMA(0, 0, At, B0); PG8_BAR; PG8_SCHED;
            PG8_LDB(B1, 1, 1); PG8_STAGE(PG8_SB(1, 0), b3, voffB);
            PG8_BAR; PG8_WAIT_L(0); PG8_MMA(0, 1, At, B1); PG8_BAR;
            PG8_LDA(At, 1, 1); PG8_STAGE(PG8_SA(1, 0), a3, voffA);
            PG8_BAR; PG8_WAIT_L(0); PG8_MMA(1, 0, At, B0); PG8_BAR; PG8_SCHED;
            PG8_STAGE(PG8_SB(1, 1), b3 + hstep, voffB);
            PG8_WAIT_V(6); PG8_BAR; PG8_MMA(1, 1, At, B1); PG8_BAR;
            }
        }
        if constexpr (ALIGN_EPI) { if (wr == 0) PG8_BAR; }
        if constexpr (!Epi::AFTER_DRAIN) { E(acc, cur, wr, wc, fr, fq); S.done(cur); }
        if (!has_next) break;
#pragma unroll
        for (int a = 0; a < 2; ++a)
#pragma unroll
            for (int b = 0; b < 2; ++b)
#pragma unroll
                for (int m = 0; m < 4; ++m)
#pragma unroll
                    for (int n = 0; n < 2; ++n) acc[a][b][m][n] = (f32x4){0.f, 0.f, 0.f, 0.f};
        cur = nxt; cA = nA; cB = nB; ++ui;
        if constexpr (ALIGN_EPI) { if (wr == 1) PG8_BAR; }
    }
    PG8_WAIT_V(0);
    if constexpr (!ALIGN_EPI) { if (wr == 0) PG8_BAR; }
    PG8_BAR;
    if constexpr (Epi::AFTER_DRAIN) { E.fused(acc, cur, wr, wc, fr, fq, lds, wid, lane); S.done(cur); }
#undef PG8_SA
#undef PG8_SB
#undef PG8_STAGE
#undef PG8_LDA
#undef PG8_LDB
#undef PG8_MMA
#undef PG8_WAIT_V
#undef PG8_WAIT_L
#undef PG8_BAR
#undef PG8_SCHED
}

__device__ __forceinline__ v4u pack8(const f32x4& a, const f32x4& b) { v4u w; w.x = cvt_pk_bf16(a[0], a[1]); w.y = cvt_pk_bf16(a[2], a[3]); w.z = cvt_pk_bf16(b[0], b[1]); w.w = cvt_pk_bf16(b[2], b[3]); return w; }
__device__ __forceinline__ float dot4(const f32x4& a) { return (a[0] * a[0] + a[1] * a[1]) + (a[2] * a[2] + a[3] * a[3]); }
struct EpiSwiglu {
    static constexpr bool PERM = true, AFTER_DRAIN = false;
    bf16_t* O; int ldo; const float* rowsq;
    __device__ __forceinline__ void operator()(const f32x4 (&acc)[2][2][4][2], const Unit& u, int wr, int wc, int fr, int fq) const {
        const int row0 = u.pm * BM + wr * 64 + fr, col0 = u.pn * HALF + wc * 32 + 8 * fq;
#pragma unroll
        for (int ai = 0; ai < 2; ++ai)
#pragma unroll
            for (int m = 0; m < 4; ++m) {
                bf16_t* rowp = O + (size_t)(row0 + ai * HALF + m * 16) * ldo + col0;
                const float ms = rowsq ? rowsq[row0 + ai * HALF + m * 16] * (1.0f / 1024.0f) + EPS : 1.0f, c1 = -1.4426950408889634f * (rowsq ? rsqrtf(ms) : 1.0f);
                f32x4 o[2]; typedef float f32x2 __attribute__((ext_vector_type(2)));
#pragma unroll
                for (int n = 0; n < 2; ++n)
#pragma unroll
                    for (int j = 0; j < 4; j += 2) { const f32x2 g = {acc[ai][0][m][n][j], acc[ai][0][m][n][j + 1]}, up = {acc[ai][1][m][n][j], acc[ai][1][m][n][j + 1]};
                        f32x2 e = g * c1; e = (f32x2){__builtin_amdgcn_exp2f(e[0]), __builtin_amdgcn_exp2f(e[1])};
                        f32x2 d = __builtin_elementwise_fma(e, (f32x2){ms, ms}, (f32x2){ms, ms}); d = (f32x2){__builtin_amdgcn_rcpf(d[0]), __builtin_amdgcn_rcpf(d[1])};
                        const f32x2 r = (g * up) * d; o[n][j] = r[0]; o[n][j + 1] = r[1]; }
                *(v4u*)rowp = pack8(o[0], o[1]);
            }
    }
};
template <bool NORM, int rs, bool HALFSTEP, bool BASEBF, bool OUTF32> struct EpiResid {
    static constexpr bool PERM = false, AFTER_DRAIN = false; static constexpr int ldc = D_; static constexpr float alpha = HALFSTEP ? 0.5f : 1.0f;
    const float* base; float* out; unsigned char* ws; const float* g1;
    __device__ __forceinline__ void operator()(const f32x4 (&acc)[2][2][4][2], const Unit& u, int wr, int wc, int fr, int fq) const {
        bf16_t* xb = (bf16_t*)(ws + WS_XN);
        f32x4 gi[2][2]; bool usexn = false;
        if (g1) {
            float gmin = 1e30f;
#pragma unroll
            for (int bj = 0; bj < 2; ++bj)
#pragma unroll
                for (int n = 0; n < 2; ++n) { const f32x4 gg = *(const f32x4*)(g1 + u.pn * BM + wc * 32 + 4 * fq + bj * HALF + n * 16);
                    gmin = fminf(gmin, fminf(fminf(fabsf(gg[0]), fabsf(gg[1])), fminf(fabsf(gg[2]), fabsf(gg[3]))));
                    gi[bj][n] = (f32x4){__builtin_amdgcn_rcpf(gg[0]), __builtin_amdgcn_rcpf(gg[1]), __builtin_amdgcn_rcpf(gg[2]), __builtin_amdgcn_rcpf(gg[3])}; }
            usexn = __all(gmin > 0.25f);
        }
#pragma unroll
        for (int ai = 0; ai < 2; ++ai)
#pragma unroll
            for (int m = 0; m < 4; ++m) {
                const int row = u.pm * BM + ai * HALF + wr * 64 + m * 16 + fr;
                const size_t ro = (size_t)row * ldc + u.pn * BM + wc * 32 + 4 * fq;
                float ss = 0.f; const float rms1 = (!BASEBF && usexn) ? ((const float*)(ws + WS_RMS1))[row] : 1.0f;
#pragma unroll
                for (int bj = 0; bj < 2; ++bj)
#pragma unroll
                    for (int n = 0; n < 2; ++n) { const size_t o = ro + bj * HALF + n * 16;
                        f32x4 bs;
                        if (BASEBF || usexn) { const v2u q = *(const v2u*)(xb + o);
                            bs = (f32x4){__builtin_bit_cast(float, q.x << 16), __builtin_bit_cast(float, q.x & 0xffff0000u), __builtin_bit_cast(float, q.y << 16), __builtin_bit_cast(float, q.y & 0xffff0000u)};
                            if (!BASEBF) bs = bs * gi[bj][n] * rms1; }
                        else bs = *(const f32x4*)(base + o);
                        const f32x4 v = bs + acc[ai][bj][m][n] * alpha;
                        if constexpr (OUTF32) *(f32x4*)(out + o) = v;
                        if constexpr (NORM) { v2u q; q.x = cvt_pk_bf16(v[0], v[1]); q.y = cvt_pk_bf16(v[2], v[3]); *(v2u*)(xb + o) = q; ss += dot4(v); } }
                if constexpr (NORM) { ss += shx<16>(ss); ss += shx<32>(ss); if (fq == 0) atomicAdd((float*)(ws + WS_ROWSQ) + (size_t)rs * NT + row, ss); }
                asm volatile("" ::: "memory");
            }
    }
};
struct EpiWin {
    static constexpr bool PERM = true, AFTER_DRAIN = false;
    unsigned char* ws; const float* rowsq;
    __device__ __forceinline__ void operator()(const f32x4 (&acc)[2][2][4][2], const Unit& u, int wr, int wc, int fr, int fq) const {
        const int tile = u.pn, rowb = u.pm * BM + wr * 64 + fr;
        if (tile <= 2) {
            const float* g = (const float*)(ws + WS_GTAB) + (tile < 2 ? 0 : (wc < 2 ? 64 : 128));
            const float ga0 = g[2 * fq], ga1 = g[2 * fq + 1], ga2 = g[8 + 2 * fq], ga3 = g[9 + 2 * fq];
            const f32x4 gb = *(const f32x4*)(g + 16 + 4 * fq), gc0 = *(const f32x4*)(g + 32 + 8 * fq), gc1 = *(const f32x4*)(g + 36 + 8 * fq);
            const float* ropec = (const float*)(ws + WS_ROPEC); const float* ropes = (const float*)(ws + WS_ROPES);
#pragma unroll
            for (int ai = 0; ai < 2; ++ai)
#pragma unroll
                for (int m = 0; m < 4; ++m) {
                    const int row = rowb + ai * HALF + m * 16, b = row >> 13, t = row & (T_ - 1);
                    const float rr = rsqrtf(rowsq[row] * (1.0f / 1024.0f) + EPS);
                    const f32x4 v0 = acc[ai][0][m][0] * rr, v1 = acc[ai][0][m][1] * rr, w0 = acc[ai][1][m][0] * rr, w1 = acc[ai][1][m][1] * rr;
                    float ss = (dot4(v0) + dot4(v1)) + (dot4(w0) + dot4(w1));
                    ss += shx<16>(ss); ss += shx<32>(ss);
                    const float r = rsqrtf(ss * (1.0f / 64.0f) + EPS) * (tile < 2 ? Q_SCALE : 1.0f);
                    const float y0 = v0[0] * r * ga0, y1 = v0[1] * r * ga1, y2 = v0[2] * r * ga2, y3 = v0[3] * r * ga3;
                    const float2 cc = *(const float2*)(ropec + (size_t)row * 8 + 2 * fq), sn = *(const float2*)(ropes + (size_t)row * 8 + 2 * fq);
                    const float o0 = y0 * cc.x - y2 * sn.x, o2 = y2 * cc.x + y0 * sn.x, o1 = y1 * cc.y - y3 * sn.y, o3 = y3 * cc.y + y1 * sn.y;
                    bf16_t* dst = tile < 2 ? (bf16_t*)(ws + WS_QN) + (size_t)row * 512 + (tile * 4 + wc) * 64
                                           : (bf16_t*)(ws + (wc < 2 ? WS_KS : WS_KW)) + ((size_t)(b * 2 + (wc & 1)) * T_ + t) * 64;
                    *(unsigned*)(dst + 2 * fq) = cvt_pk_bf16(o0, o1);
                    *(unsigned*)(dst + 8 + 2 * fq) = cvt_pk_bf16(o2, o3);
                    v2u q; q.x = cvt_pk_bf16(v1[0] * r * gb[0], v1[1] * r * gb[1]); q.y = cvt_pk_bf16(v1[2] * r * gb[2], v1[3] * r * gb[3]);
                    *(v2u*)(dst + 16 + 4 * fq) = q;
                    *(v4u*)(dst + 32 + 8 * fq) = pack8(w0 * r * gc0, w1 * r * gc1);
                }
        } else if (tile == 5) {
            if (wc == 0 && fq < 3) {
                float* G = (float*)(ws + WS_GATES);
#pragma unroll
                for (int ai = 0; ai < 2; ++ai)
#pragma unroll
                    for (int m = 0; m < 4; ++m) {
                        const int row = rowb + ai * HALF + m * 16; const float rr = rsqrtf(rowsq[row] * (1.0f / 1024.0f) + EPS);
#pragma unroll
                        for (int n = 0; n < 2; ++n) { f32x4 o;
#pragma unroll
                            for (int j = 0; j < 4; ++j) o[j] = __builtin_amdgcn_rcpf(1.0f + __builtin_amdgcn_exp2f(-1.4426950408889634f * rr * acc[ai][0][m][n][j]));
                            *(f32x4*)(G + (size_t)row * 24 + 8 * fq + 4 * n) = o; }
                    }
            }
        } else {
            const int c0 = 32 * wc + 8 * fq;
#pragma unroll
            for (int ai = 0; ai < 2; ++ai)
#pragma unroll
                for (int m = 0; m < 4; ++m) {
                    const int row = rowb + ai * HALF + m * 16, b = row >> 13, t = row & (T_ - 1);
                    bf16_t *d0, *d1;
                    if (tile == 3 || tile == 4) {
                        const size_t o = ((size_t)(b * 2 + (wc >> 1)) * T_ + t) * 64 + (c0 & 63);
                        d0 = (bf16_t*)(ws + (tile == 3 ? WS_KCR : WS_VS)) + o; d1 = (bf16_t*)(ws + (tile == 3 ? WS_VCR : WS_VW)) + o;
                    } else if (tile < 8) {
                        d0 = (bf16_t*)(ws + WS_QS) + (size_t)row * 512 + (tile - 6) * 256 + c0; d1 = d0 + 128;
                    } else {
                        const int tb = tile < 10 ? tile - 8 : tile - 10;
                        const int col0 = tb * 256 + c0, col1 = col0 + 128;
                        bf16_t* base = (bf16_t*)(ws + (tile < 10 ? WS_KSB : WS_VSB));
                        d0 = base + ((size_t)(b * 8 + (col0 >> 6)) * T_ + t) * 64 + (col0 & 63);
                        d1 = base + ((size_t)(b * 8 + (col1 >> 6)) * T_ + t) * 64 + (col1 & 63);
                    }
                    const float sc = ((tile == 6 || tile == 7) ? Q_SCALE : 1.0f) * rsqrtf(rowsq[row] * (1.0f / 1024.0f) + EPS);
                    *(v4u*)d0 = pack8(acc[ai][0][m][0] * sc, acc[ai][0][m][1] * sc);
                    *(v4u*)d1 = pack8(acc[ai][1][m][0] * sc, acc[ai][1][m][1] * sc);
                }
        }
    }
};
struct EpiHeadNorm {
    static constexpr bool PERM = true, AFTER_DRAIN = false;
    bf16_t* O0; bf16_t* O1; const float* g; float scale; const float* rowsq;
    __device__ __forceinline__ void operator()(const f32x4 (&acc)[2][2][4][2], const Unit& u, int wr, int wc, int fr, int fq) const {
        const int rowb = u.pm * BM + wr * 64 + fr;
        const f32x4 g0 = *(const f32x4*)(g + 8 * fq), g1 = *(const f32x4*)(g + 8 * fq + 4), g2 = *(const f32x4*)(g + 32 + 8 * fq), g3 = *(const f32x4*)(g + 36 + 8 * fq);
#pragma unroll
        for (int ai = 0; ai < 2; ++ai)
#pragma unroll
            for (int m = 0; m < 4; ++m) {
                const int row = rowb + ai * HALF + m * 16; const float rr = rowsq ? rsqrtf(rowsq[row] * (1.0f / 1024.0f) + EPS) : 1.0f;
                const f32x4 v0 = acc[ai][0][m][0] * rr, v1 = acc[ai][0][m][1] * rr, w0 = acc[ai][1][m][0] * rr, w1 = acc[ai][1][m][1] * rr;
                if (u.pn == 0) {
                    float ss = (dot4(v0) + dot4(v1)) + (dot4(w0) + dot4(w1));
                    ss += shx<16>(ss); ss += shx<32>(ss);
                    const float r = rsqrtf(ss * (1.0f / 64.0f) + EPS) * scale;
                    bf16_t* dst = O0 + (size_t)row * 256 + wc * 64;
                    *(v4u*)(dst + 8 * fq) = pack8(v0 * r * g0, v1 * r * g1);
                    *(v4u*)(dst + 32 + 8 * fq) = pack8(w0 * r * g2, w1 * r * g3);
                } else {
                    bf16_t* dst = O1 + (size_t)row * 256 + 32 * wc + 8 * fq;
                    *(v4u*)dst = pack8(v0, v1);
                    *(v4u*)(dst + 128) = pack8(w0, w1);
                }
            }
    }
};
struct EpiCmp1 {
    static constexpr bool PERM = true, AFTER_DRAIN = false;
    bf16_t* O; const float* bias;
    __device__ __forceinline__ void operator()(const f32x4 (&acc)[2][2][4][2], const Unit& u, int wr, int wc, int fr, int fq) const {
        const int rowb = u.pm * BM + wr * 64 + fr, c0 = 32 * wc + 8 * fq;
#pragma unroll
        for (int bj = 0; bj < 2; ++bj) {
            const f32x4 b0 = *(const f32x4*)(bias + bj * HALF + c0), b1 = *(const f32x4*)(bias + bj * HALF + c0 + 4);
#pragma unroll
            for (int ai = 0; ai < 2; ++ai)
#pragma unroll
                for (int m = 0; m < 4; ++m) {
                    f32x4 x0 = acc[ai][bj][m][0] + b0, x1 = acc[ai][bj][m][1] + b1;
#pragma unroll
                    for (int j = 0; j < 4; ++j) { x0[j] = gelu_tanh(x0[j]); x1[j] = gelu_tanh(x1[j]); }
                    *(v4u*)(O + (size_t)(rowb + ai * HALF + m * 16) * 256 + bj * HALF + c0) = pack8(x0, x1);
                }
        }
    }
};
struct OffsetOrder {
    int c, base, nM, nN;
    __device__ __forceinline__ bool next(int i, Unit& u) const { if (i != 0) return false; const int k = c - base; if (k < 0 || k >= nM * nN) return false; u.pm = k / nN; u.pn = k % nN; return true; }
    __device__ __forceinline__ void a_ready(const Unit&) const {}
    __device__ __forceinline__ void done(const Unit&) const {}
};
}


#define XB_TMO      128
#define XB_XCNT(j)  (256  + 64 * (j))
#define XB_XSUB(j)  (1280 + 64 * (j))
#define XB_XGEN(j)  (2304 + 64 * (j))
#define XB_TOP      3328
#define XB_TOPGEN   3392
#define XCD_BAR_WORDS 3456
#define XB_SPIN_CAP (1u << 18)

__device__ __forceinline__ unsigned xb_ld(unsigned* p)              { return __hip_atomic_load(p, __ATOMIC_RELAXED, __HIP_MEMORY_SCOPE_AGENT); }
__device__ __forceinline__ unsigned xb_add(unsigned* p, unsigned v) { return __hip_atomic_fetch_add(p, v, __ATOMIC_RELAXED, __HIP_MEMORY_SCOPE_AGENT); }
__device__ __forceinline__ unsigned xb_xcc_id() { return (unsigned)__builtin_amdgcn_s_getreg((3 << 11) | 20) & 0xFu; }
#define XB_SPIN(cond, bar) do { unsigned _sp = 0; while (cond) { __builtin_amdgcn_s_sleep(1); \
    if ((++_sp & 255u) == 0u) { if (xb_ld(&(bar)[XB_TMO])) break; if (_sp > XB_SPIN_CAP) { atomicAdd(&(bar)[XB_TMO], 1u); break; } } } } while (0)

struct XcdBarrier {
    unsigned* bar; unsigned x;
    volatile LAS unsigned* st;
};

__device__ __forceinline__ XcdBarrier xcd_barrier_post(unsigned* bar, volatile LAS unsigned* st) {
    XcdBarrier b; b.bar = bar; b.x = xb_xcc_id(); b.st = st;
    if (tid_() == 0) (void)xb_add(&bar[XB_XCNT(b.x)], 1u);
    return b;
}
__device__ __forceinline__ void xcd_barrier_complete(unsigned* bar, unsigned x, unsigned& nloc, unsigned& nx) {
    const unsigned G = gridDim.x * gridDim.y * gridDim.z;
    unsigned sum, cnt, mine, sp = 0u;
    for (;;) {
        sum = 0u; cnt = 0u; mine = 0u;
#pragma unroll
        for (unsigned j = 0; j < 16; ++j) { const unsigned c = xb_ld(&bar[XB_XCNT(j)]); sum += c; cnt += (c > 0u) ? 1u : 0u; mine = (j == x) ? c : mine; }
        if (sum == G) break;
        __builtin_amdgcn_s_sleep(1);
        if ((++sp & 255u) == 0u) { if (xb_ld(&bar[XB_TMO])) break; if (sp > XB_SPIN_CAP) { atomicAdd(&bar[XB_TMO], 1u); break; } }
    }
    nloc = mine > 0u ? mine : 1u; nx = cnt > 0u ? cnt : 1u;
}

__device__ __forceinline__ void xcd_barrier(const XcdBarrier& b) {
    asm volatile("s_waitcnt vmcnt(0)" ::: "memory");
    __syncthreads();
    if (tid_() == 0) {
        unsigned* bar = b.bar;
        __builtin_amdgcn_s_waitcnt(0);
        unsigned nloc = b.st[0], nx = b.st[1];
        if (nloc == 0u) { xcd_barrier_complete(bar, b.x, nloc, nx); b.st[0] = nloc; b.st[1] = nx; }
        const unsigned old = xb_add(&bar[XB_XSUB(b.x)], 1u);
        const unsigned gen = old / nloc;
        if (old + 1u == (gen + 1u) * nloc) {
            __builtin_amdgcn_fence(__ATOMIC_RELEASE, "agent");
            asm volatile("s_waitcnt vmcnt(0)" ::: "memory");
            const unsigned og = xb_add(&bar[XB_TOP], 1u);
            const unsigned tg = og / nx;
            if (og + 1u == (tg + 1u) * nx) xb_add(&bar[XB_TOPGEN], 1u);
            else XB_SPIN(xb_ld(&bar[XB_TOPGEN]) == tg, bar);
            __builtin_amdgcn_fence(__ATOMIC_ACQUIRE, "agent");
            xb_add(&bar[XB_XGEN(b.x)], 1u);
            asm volatile("s_waitcnt vmcnt(0)" ::: "memory");
        } else {
            if (old == gen * nloc) {
                __builtin_amdgcn_fence(__ATOMIC_RELEASE, "agent");
                asm volatile("s_waitcnt vmcnt(0)" ::: "memory"); }
            __builtin_amdgcn_fence(__ATOMIC_ACQUIRE, "agent");
            XB_SPIN(xb_ld(&bar[XB_XGEN(b.x)]) == gen, bar);
            asm volatile("s_waitcnt vmcnt(0)" ::: "memory");
        }
    }
    __syncthreads();
}


template <class RowMap>
__device__ __forceinline__ void transpose_item(const float* W, int K, int N, bf16* WT, LAS float* scr, int item2, int lane, const RowMap& rowmap, const float* gk = nullptr) {
    const int nblk = (N + 31) / 32; const int c4 = lane & 7, c = lane & 7;
    typedef float f4v __attribute__((ext_vector_type(4)));
    f4v v[2][8];
#pragma unroll
    for (int q = 0; q < 2; ++q) { const int item = 2 * item2 + q, kb = item / nblk, nb = item % nblk, k0 = 64 * kb, n0 = 32 * nb; const bool okn = n0 + 4 * c4 < N;
#pragma unroll
        for (int i = 0; i < 8; ++i) { const int kk = 8 * i + (lane >> 3);
            v[q][i] = (f4v){0.f, 0.f, 0.f, 0.f};
            if (okn) v[q][i] = __builtin_nontemporal_load((const f4v*)(W + (size_t)(k0 + kk) * N + n0 + 4 * c4)); } }
#pragma unroll
    for (int q = 0; q < 2; ++q) { const int item = 2 * item2 + q, kb = item / nblk, k0 = 64 * kb; LAS float* sc = scr + q * (64 * 33);
#pragma unroll
        for (int i = 0; i < 8; ++i) { const int kk = 8 * i + (lane >> 3); f4v t = v[q][i];
            if (gk) t = t * gk[k0 + kk];
            LAS float* d = sc + kk * 33 + 4 * c4; d[0] = t[0]; d[1] = t[1]; d[2] = t[2]; d[3] = t[3]; } }
    asm volatile("s_waitcnt lgkmcnt(0)" ::: "memory");
#pragma unroll
    for (int q = 0; q < 2; ++q) { const int item = 2 * item2 + q, kb = item / nblk, nb = item % nblk, k0 = 64 * kb, n0 = 32 * nb; const LAS float* sc = scr + q * (64 * 33);
#pragma unroll
        for (int j = 0; j < 4; ++j) { const int n = (lane >> 3) + 8 * j; const LAS float* sp = sc + (8 * c) * 33 + n;
            v4u o; o.x = pk2(sp[0 * 33], sp[1 * 33]); o.y = pk2(sp[2 * 33], sp[3 * 33]); o.z = pk2(sp[4 * 33], sp[5 * 33]); o.w = pk2(sp[6 * 33], sp[7 * 33]);
            if (n0 + n < N) *(v4u*)(WT + (size_t)rowmap(n0 + n) * K + k0 + 8 * c) = o; } }
    asm volatile("s_waitcnt lgkmcnt(0)" ::: "memory");
}
struct RmGate { __device__ int operator()(int n) const { return (n >> 7) * 256 + (n & 127); } };
struct RmUp { __device__ int operator()(int n) const { return (n >> 7) * 256 + 128 + (n & 127); } };
struct RmOff { int off; __device__ int operator()(int n) const { return n + off; } };
struct RmMemHead { __device__ int operator()(int n) const { return colmap_head(n >> 6, n & 63); } };
struct RmWin { __device__ int operator()(int n) const {
    if (n < C_KC) { const int h = n >> 6, d = n & 63; return (h >> 2) * 256 + colmap_rope(h & 3, d); }
    if (n < C_VC) return 3 * 256 + (n - C_KC);
    if (n < C_KS) return 3 * 256 + 128 + (n - C_VC);
    if (n < C_VS) { const int k = n - C_KS; return 2 * 256 + colmap_rope(k >> 6, k & 63); }
    if (n < C_KW) return 4 * 256 + (n - C_VS);
    if (n < C_VW) { const int k = n - C_KW; return 2 * 256 + colmap_rope(2 + (k >> 6), k & 63); }
    if (n < C_GT) return 4 * 256 + 128 + (n - C_VW);
    if (n < C_QS) return 5 * 256 + (n - C_GT);
    if (n < C_KSB) return 6 * 256 + (n - C_QS);
    if (n < C_VSB) return 8 * 256 + (n - C_KSB);
    return 10 * 256 + (n - C_VSB);
} };
__device__ __forceinline__ void ph_rmsnorm_bf16(const float* X, const float* g, bf16* O, int rows, float* rms_out = nullptr) {
    const int lane = tid_() & 63, wv = tid_() >> 6; const int S = gridDim.x * NWV;
    typedef float f4v __attribute__((ext_vector_type(4)));
    for (int r0 = blockIdx.x * NWV + wv; r0 < rows; r0 += 4 * S) {
        f4v v[4][4];
#pragma unroll
        for (int q = 0; q < 4; ++q) { const int r = r0 + q * S;
            if (r < rows) {
#pragma unroll
                for (int j = 0; j < 4; ++j) v[q][j] = __builtin_nontemporal_load((const f4v*)(X + (size_t)r * D_) + lane + 64 * j); } }
#pragma unroll
        for (int q = 0; q < 4; ++q) { const int r = r0 + q * S;
            if (r < rows) {
                float ss = 0.f;
#pragma unroll
                for (int j = 0; j < 4; ++j) ss += v[q][j][0] * v[q][j][0] + v[q][j][1] * v[q][j][1] + v[q][j][2] * v[q][j][2] + v[q][j][3] * v[q][j][3];
                const float ms = wave_sum(ss) * (1.f / D_) + EPS, rs = rsqrtf(ms);
                if (rms_out && lane == 0) rms_out[r] = sqrtf(ms);
                unsigned long long* o8 = (unsigned long long*)(O + (size_t)r * D_);
#pragma unroll
                for (int j = 0; j < 4; ++j) { const float4 gg = ((const float4*)g)[lane + 64 * j];
                    o8[lane + 64 * j] = (unsigned long long)pk2(v[q][j][0] * rs * gg.x, v[q][j][1] * rs * gg.y) | ((unsigned long long)pk2(v[q][j][2] * rs * gg.z, v[q][j][3] * rs * gg.w) << 32); } } }
    }
}
struct ConvItems {
    static constexpr int I_G = (D_ / 64) * (FF / 32) / 2, I_D = (FF / 64) * (D_ / 32) / 2, I_IN = (D_ / 64) * ((INC + 31) / 32) / 2, I_OUT = (D_ / 64) * (D_ / 32) / 2, I_M = (D_ / 64) * (256 / 32) / 2, I_MO = (256 / 64) * (D_ / 32) / 2, I_C1 = (2048 / 64) * (256 / 32) / 2;
    static constexpr int NITEMS = 4 * I_G + 2 * I_D + I_IN + I_OUT + 3 * I_M + I_MO + 2 * I_C1;
    static constexpr int FFN2_LO = 2 * I_G + I_D, FFN2_HI = 4 * I_G + 2 * I_D;
};
__device__ __forceinline__ void conv_item(const Params& p, unsigned char* ws, LAS float* scr, int lane, int r) {
    constexpr int I_G = ConvItems::I_G, I_D = ConvItems::I_D, I_IN = ConvItems::I_IN, I_OUT = ConvItems::I_OUT, I_M = ConvItems::I_M, I_MO = ConvItems::I_MO, I_C1 = ConvItems::I_C1;
    static_assert(((D_ / 64) * ((INC + 31) / 32)) % 2 == 0 && ((FF / 32) % 2) == 0, "items go in pairs");
    if (r < I_G) { transpose_item(p.in[4], D_, FF, (bf16*)(ws + WS_WGU1), scr, r, lane, RmGate()); return; } r -= I_G;
    if (r < I_G) { transpose_item(p.in[5], D_, FF, (bf16*)(ws + WS_WGU1), scr, r, lane, RmUp()); return; } r -= I_G;
    if (r < I_D) { transpose_item(p.in[6], FF, D_, (bf16*)(ws + WS_WD1), scr, r, lane, RmOff{0}); return; } r -= I_D;
    if (r < I_G) { transpose_item(p.in[29], D_, FF, (bf16*)(ws + WS_WGU2), scr, r, lane, RmGate(), p.in[28]); return; } r -= I_G;
    if (r < I_G) { transpose_item(p.in[30], D_, FF, (bf16*)(ws + WS_WGU2), scr, r, lane, RmUp(), p.in[28]); return; } r -= I_G;
    if (r < I_D) { transpose_item(p.in[31], FF, D_, (bf16*)(ws + WS_WD2), scr, r, lane, RmOff{0}); return; } r -= I_D;
    if (r < I_IN) { transpose_item(p.in[8], D_, INC, (bf16*)(ws + WS_WIN), scr, r, lane, RmWin(), p.in[7]); return; } r -= I_IN;
    if (r < I_OUT) { transpose_item(p.in[19], D_, D_, (bf16*)(ws + WS_WOUT), scr, r, lane, RmOff{0}); return; } r -= I_OUT;
    if (r < I_M) { transpose_item(p.in[22], D_, 256, (bf16*)(ws + WS_WMQ), scr, r, lane, RmMemHead(), p.in[20]); return; } r -= I_M;
    if (r < I_M) { transpose_item(p.in[23], D_, 256, (bf16*)(ws + WS_WMKV), scr, r, lane, RmMemHead()); return; } r -= I_M;
    if (r < I_M) { transpose_item(p.in[24], D_, 256, (bf16*)(ws + WS_WMKV), scr, r, lane, RmOff{256}); return; } r -= I_M;
    if (r < I_MO) { transpose_item(p.in[27], 256, D_, (bf16*)(ws + WS_WMO), scr, r, lane, RmOff{0}); return; } r -= I_MO;
    if (r < I_C1) { transpose_item(p.in[14], 2048, 256, (bf16*)(ws + WS_WC1K), scr, r, lane, RmOff{0}); return; } r -= I_C1;
    transpose_item(p.in[17], 2048, 256, (bf16*)(ws + WS_WC1V), scr, r, lane, RmOff{0});
}
__device__ __forceinline__ void ph_conv_ffn2(const Params& p, LAS unsigned char* lds, int first, int count) {
    const int c = (int)blockIdx.x - first; if (c < 0 || c >= count) return;
    const int lane = tid_() & 63, wv = tid_() >> 6;
    LAS float* scr = (LAS float*)(lds + wv * 17408);
    for (int r = ConvItems::FFN2_LO + c * NWV + wv; r < ConvItems::FFN2_HI; r += count * NWV) conv_item(p, p.ws, scr, lane, r);
}
__device__ __forceinline__ void ph_prologue(const Params& p, LAS unsigned char* lds) {
    const int lane = tid_() & 63, wv = tid_() >> 6;
    LAS float* scr = (LAS float*)(lds + wv * 17408);
    unsigned char* ws = p.ws;
    constexpr int NP0 = ConvItems::NITEMS - (ConvItems::FFN2_HI - ConvItems::FFN2_LO);
    for (int it = blockIdx.x * NWV + wv; it < NP0; it += gridDim.x * NWV) conv_item(p, ws, scr, lane, it < ConvItems::FFN2_LO ? it : it + (ConvItems::FFN2_HI - ConvItems::FFN2_LO));
    float* rc = (float*)(ws + WS_ROPEC); float* rs = (float*)(ws + WS_ROPES);
    for (int i = blockIdx.x * NTHR + tid_(); i < NT * 8; i += gridDim.x * NTHR) {
        const float ang = (float)p.pos[i >> 3] * ROPE_FREQ[i & 7];
        float s, c; sincos_acc(ang, s, c); rc[i] = c; rs[i] = s;
    }
    for (int i = blockIdx.x * NTHR + tid_(); i < 3 * NT; i += gridDim.x * NTHR) ((float*)(ws + WS_ROWSQ))[i] = 0.f;
    if (blockIdx.x < 64) {
        const int i = tid_(), kv = i >> 8, j = i & 255; const float* pe = kv ? p.in[16] : p.in[13]; const float* w1 = kv ? p.in[17] : p.in[14];
        float a = 0.f;
#pragma unroll 8
        for (int k = 32 * blockIdx.x; k < 32 * blockIdx.x + 32; ++k) a = fmaf(pe[k], w1[(size_t)k * 256 + j], a);
        ((float*)(ws + WS_BIASP))[blockIdx.x * 512 + i] = a;
    }
    for (int i = blockIdx.x * NTHR + tid_(); i < 2 * 64 * 256; i += gridDim.x * NTHR) { const int kv = i >> 14, n = (i >> 8) & 63, k = i & 255; ((bf16*)(ws + WS_W2T))[i] = (bf16)f2bf((kv ? p.in[18] : p.in[15])[k * 64 + n]); }
    if (blockIdx.x == 1 && tid_() < 64) {
        const int l_ = tid_(); float* gm = (float*)(ws + WS_GMAX);
        const float m0 = wave_max(fabsf(p.in[9][l_])), m1 = wave_max(fabsf(p.in[10][l_])), m2 = wave_max(fabsf(p.in[11][l_])), m3 = wave_max(fabsf(p.in[12][l_])), m4 = wave_max(fabsf(p.in[25][l_])), m5 = wave_max(fabsf(p.in[26][l_]));
        if (l_ == 0) { gm[0] = m0; gm[1] = m1; gm[2] = m2; gm[3] = m3; gm[4] = m4; gm[5] = m5; } }
    if (blockIdx.x == 0 && tid_() < 64) { float* gt = (float*)(ws + WS_GTAB); gt[tid_()] = p.in[9][tid_()]; gt[64 + tid_()] = p.in[11][tid_()]; gt[128 + tid_()] = p.in[12][tid_()]; }
    ph_rmsnorm_bf16(p.in[1], p.in[21], (bf16*)(ws + WS_XN) + (size_t)NT * D_, NMEM);
    ph_rmsnorm_bf16(p.in[0], p.in[3], (bf16*)(ws + WS_XN), NT, (float*)(ws + WS_RMS1));
}

__device__ __forceinline__ void ph_bias_finish(const Params& p) {
    if (blockIdx.x == 0) { const int i = tid_(); const float* part = (const float*)(p.ws + WS_BIASP); float a = 0.f;
#pragma unroll 8
        for (int b = 0; b < 64; ++b) a += part[b * 512 + i];
        ((float*)(p.ws + WS_BIASC))[i] = a; }
}

__device__ __forceinline__ void ph_cmp2(const Params& p) {
    const bf16* HC = (const bf16*)(p.ws + WS_HC);
    const float* rc = (const float*)(p.ws + WS_ROPEC); const float* rs = (const float*)(p.ws + WS_ROPES);
    const int lane = tid_() & 63, wv = tid_() >> 6;
    for (int it = blockIdx.x * NWV + wv; it < 2 * 8 * NCMP; it += gridDim.x * NWV) {
        const int kv = it / (8 * NCMP), rem = it % (8 * NCMP), bh = rem / NCMP, n = rem % NCMP, b = bh >> 1;
        const float* w2 = kv ? p.in[18] : p.in[15];
        const bf16* h = HC + ((size_t)(kv * 8 + bh) * 512 + n) * 256;
        float acc = 0.f;
        for (int jj = 0; jj < 256; ++jj) acc = fmaf(bf2f(h[jj]), w2[jj * 64 + lane], acc);
        if (kv) { ((bf16*)(p.ws + WS_VCB))[((size_t)bh * 512 + n) * 64 + lane] = (bf16)f2bf(acc); continue; }
        const float r = rsqrtf(wave_sum(acc * acc) * (1.f / 64.f) + EPS);
        float y = acc * r * p.in[10][lane];
        const float yp = shx<8>(y);
        const int m = b * T_ + 16 * n + 31;
        if (lane < 16) { const float c = rc[m * 8 + (lane & 7)], s = rs[m * 8 + (lane & 7)]; y = (lane < 8) ? (y * c - yp * s) : (y * c + yp * s); }
        ((bf16*)(p.ws + WS_KCB))[((size_t)bh * 512 + n) * 64 + lane] = (bf16)f2bf(y);
    }
}

namespace fa {
typedef short bf16x8 __attribute__((ext_vector_type(8)));
typedef short s16x4 __attribute__((ext_vector_type(4)));
typedef float f32x16 __attribute__((ext_vector_type(16)));
typedef short v4i16_t __attribute__((ext_vector_type(4)));
typedef LAS const char* lptr;
typedef float f32x4v __attribute__((ext_vector_type(4)));
__device__ __forceinline__ int crow(int r, int hi) { return (r & 3) + 8 * (r >> 2) + 4 * hi; }
__device__ __forceinline__ unsigned cvtpk(float lo, float hi) { unsigned r; asm volatile("v_cvt_pk_bf16_f32 %0, %1, %2" : "=v"(r) : "v"(lo), "v"(hi)); return r; }
__device__ __forceinline__ unsigned wave_or(unsigned v) {
    int x = (int)v; x |= shxi<1>(x); x |= shxi<2>(x); x |= shxi<4>(x); x |= shxi<8>(x); x |= shxi<16>(x); x |= shxi<32>(x);
    return (unsigned)__builtin_amdgcn_readfirstlane(x);
}
struct KVRegs { v4u k, v; };
__device__ __forceinline__ void kv_load(KVRegs& r, const bf16* Kg, const bf16* Vg, int ldk, int ldv, int tid) {
    r.k = *(const v4u*)(Kg + (size_t)(tid >> 3) * ldk + (tid & 7) * 8);
    r.v = *(const v4u*)(Vg + (size_t)(tid >> 3) * ldv + (tid & 7) * 8);
}
__device__ __forceinline__ void kv_store(const KVRegs& r, LAS char* Kb, LAS char* Vb, int tid) {
    const int key = tid >> 3, c = tid & 7;
    *(LAS v4u*)(Kb + c * 1024 + ((key ^ c) * 16)) = r.k;
    *(LAS v4u*)(Vb + (c >> 2) * 4096 + key * 64 + (((c & 3) * 16) ^ (((key >> 2) & 1) << 5))) = r.v;
}
__device__ __forceinline__ void qk_tile(f32x16& p0, f32x16& p1, lptr Kb, const bf16x8 (&qf)[4], int r32, int hi) {
    lptr kb = Kb + hi * 1024;
    f32x16 a = {}, b = {};
#pragma unroll
    for (int d0 = 0; d0 < 4; ++d0) {
        const int ko = (r32 ^ (2 * d0 + hi)) * 16;
        const bf16x8 b0 = *(LAS const bf16x8*)(kb + d0 * 2048 + ko), b1 = *(LAS const bf16x8*)(kb + d0 * 2048 + 512 + ko);
        a = __builtin_amdgcn_mfma_f32_32x32x16_bf16(b0, qf[d0], a, 0, 0, 0);
        b = __builtin_amdgcn_mfma_f32_32x32x16_bf16(b1, qf[d0], b, 0, 0, 0);
    }
    p0 = a; p1 = b;
}
__device__ __forceinline__ void qk_tile_c(f32x16& p0, f32x16& p1, lptr Kb, const bf16x8 (&qf)[4], int r32, int hi, const f32x16& c) {
    lptr kb = Kb + hi * 1024;
    f32x16 a = c, b = c;
#pragma unroll
    for (int d0 = 0; d0 < 4; ++d0) {
        const int ko = (r32 ^ (2 * d0 + hi)) * 16;
        const bf16x8 b0 = *(LAS const bf16x8*)(kb + d0 * 2048 + ko), b1 = *(LAS const bf16x8*)(kb + d0 * 2048 + 512 + ko);
        a = __builtin_amdgcn_mfma_f32_32x32x16_bf16(b0, qf[d0], a, 0, 0, 0);
        b = __builtin_amdgcn_mfma_f32_32x32x16_bf16(b1, qf[d0], b, 0, 0, 0);
    }
    p0 = a; p1 = b;
}
__device__ __forceinline__ s16x4 vtr(lptr p) { return __builtin_bit_cast(s16x4, __builtin_amdgcn_ds_read_tr16_b64_v4i16((LAS v4i16_t*)p)); }
__device__ __forceinline__ void pv_tile(f32x16 (&o)[2], lptr Vb, const v4u (&pw)[4], int lane, int hi) {
    lptr vp = Vb + ((((lane >> 4) & 1) * 32) ^ (hi << 5)) + (lane & 3) * 8 + (4 * hi + ((lane & 15) >> 2)) * 64;
#pragma unroll
    for (int d0 = 0; d0 < 2; ++d0)
#pragma unroll
        for (int s = 0; s < 4; ++s) {
            const s16x4 lo = vtr(vp + d0 * 4096 + s * 1024), hh = vtr(vp + d0 * 4096 + s * 1024 + 512);
            const bf16x8 vf = {lo[0], lo[1], lo[2], lo[3], hh[0], hh[1], hh[2], hh[3]};
            o[d0] = __builtin_amdgcn_mfma_f32_32x32x16_bf16(__builtin_bit_cast(bf16x8, pw[s]), vf, o[d0], 0, 0, 0);
        }
}
__device__ __forceinline__ void pack_p(v4u (&pw)[4], const f32x16& p0, const f32x16& p1) {
    pw[0] = (v4u){cvtpk(p0[0], p0[1]), cvtpk(p0[2], p0[3]), cvtpk(p0[4], p0[5]), cvtpk(p0[6], p0[7])};
    pw[1] = (v4u){cvtpk(p0[8], p0[9]), cvtpk(p0[10], p0[11]), cvtpk(p0[12], p0[13]), cvtpk(p0[14], p0[15])};
    pw[2] = (v4u){cvtpk(p1[0], p1[1]), cvtpk(p1[2], p1[3]), cvtpk(p1[4], p1[5]), cvtpk(p1[6], p1[7])};
    pw[3] = (v4u){cvtpk(p1[8], p1[9]), cvtpk(p1[10], p1[11]), cvtpk(p1[12], p1[13]), cvtpk(p1[14], p1[15])};
}
__device__ __forceinline__ float max_abs64(const float* g, int lane) { return wave_max(fabsf(g[lane])); }
#define FA_BAR() do { asm volatile("s_waitcnt lgkmcnt(0)" ::: "memory"); __builtin_amdgcn_s_barrier(); asm volatile("" ::: "memory"); } while (0)

#define TOF_ID(n) (n)
#define KV_PIPE_D(DEPTH, CNT, TILE_OF, KG, VG, LDK, LDV, TSK, TSV, BODY) do { \
    KVRegs kq_[DEPTH]; const int cnt_ = (CNT); bool stop_ = false; \
    _Pragma("unroll") for (int k_ = 0; k_ < (DEPTH); ++k_) if (k_ < cnt_) { const int jj_ = TILE_OF(k_); kv_load(kq_[k_], (KG) + (size_t)jj_ * (TSK), (VG) + (size_t)jj_ * (TSV), (LDK), (LDV), tid); } \
    _Pragma("unroll 1") for (int n_ = 0; n_ < cnt_ && !stop_; n_ += (DEPTH)) { \
        _Pragma("unroll") for (int k_ = 0; k_ < (DEPTH); ++k_) { if (n_ + k_ < cnt_ && !stop_) { \
            const int j = TILE_OF(n_ + k_); \
            LAS char* Kb = L + (it & 1) * 8192; LAS char* Vb = L + 16384 + (it & 1) * 8192; ++it; \
            kv_store(kq_[k_], Kb, Vb, tid); FA_BAR(); \
            if (n_ + k_ + (DEPTH) < cnt_) { const int jn_ = TILE_OF(n_ + k_ + (DEPTH)); kv_load(kq_[k_], (KG) + (size_t)jn_ * (TSK), (VG) + (size_t)jn_ * (TSV), (LDK), (LDV), tid); } \
            BODY \
        } } } } while (0)
}


struct VcuMap { const unsigned* tab; bool ok; __device__ __forceinline__ int operator()(int c) const { return ok ? (int)tab[c] : c; } };
__device__ __forceinline__ VcuMap vcu_map(const Params& p) {
    const unsigned* ctl = (const unsigned*)(p.ws + WS_CTL);
    unsigned bad = gridDim.x == 256 ? 0u : 1u;
    unsigned v[8];
#pragma unroll
    for (int x = 0; x < 8; ++x) v[x] = __hip_atomic_load(ctl + CW_XRANK + 64 * x, __ATOMIC_RELAXED, __HIP_MEMORY_SCOPE_AGENT);
#pragma unroll
    for (int x = 0; x < 8; ++x) bad |= v[x] ^ 32u;
    return VcuMap{ctl + CW_VCU, bad == 0u};
}
#define BODY_CMP \
{ \
                f32x16 p0, p1; qk_tile_c(p0, p1, Kb, qf, r32, hi, negM2v);        \
                if (64 * j + 64 <= nvmin) {                                         \
_Pragma("unroll") \
                    for (int r = 0; r < 16; ++r) { p0[r] = __builtin_amdgcn_exp2f(p0[r]); p1[r] = __builtin_amdgcn_exp2f(p1[r]); } \
                } else { \
                    const int nb = 64 * j + 4 * hi; \
_Pragma("unroll") \
                    for (int r = 0; r < 16; ++r) { \
                        const int n0 = nb + (r & 3) + 8 * (r >> 2), n1 = n0 + 32; \
                        p0[r] = n0 < nv ? __builtin_amdgcn_exp2f(p0[r]) : 0.f; p1[r] = n1 < nv ? __builtin_amdgcn_exp2f(p1[r]) : 0.f; \
                    } \
                } \
                if (pass == 0) { \
                    float s0 = 0.f, s1 = 0.f, s2 = 0.f, s3 = 0.f; \
_Pragma("unroll") \
                    for (int r = 0; r < 16; r += 2) { s0 += p0[r]; s1 += p0[r + 1]; s2 += p1[r]; s3 += p1[r + 1]; } \
                    l += (s0 + s1) + (s2 + s3); \
                } else {                                                            \
                    v4u pw[4]; pack_p(pw, p0, p1); \
                    pv_tile(o, Vb, pw, lane, hi); \
_Pragma("unroll") \
                    for (int k = 0; k < 8; ++k) { \
                            const f32x16& P = (k >> 2) ? p1 : p0; const int uu = k & 3; \
                            float bb = hinv * P[4 * uu + 3], a = fmaf((P[4 * uu] + P[4 * uu + 1]) + P[4 * uu + 2], inv, bb); \
                            a += shx<1>(a); a += shx<2>(a); bb += shx<1>(bb); bb += shx<2>(bb); \
                            const float pbb = shx<32>(bb); \
                            a += hi ? pbb : prevp; prevp = pbb; \
                            if (g == 0) IMP[tkl * IMPS + 16 * j + hi + (k >> 2) * 8 + (k & 3) * 2 - 1] = a; \
                    } \
                } \
            }
namespace fa {
__device__ __forceinline__ void store_tile_bf16(LAS float* stg, const f32x16 (&o)[2], const LAS float* wsf, int lane, int r32, int hi, bf16* base, int s_hi, int s_lo) {
    LDS_FENCE();
#pragma unroll
    for (int r = 0; r < 16; ++r) { const int q = crow(r, hi); const float f = wsf ? wsf[q] : 1.0f; stg[q * 64 + r32] = f * o[0][r]; stg[q * 64 + 32 + r32] = f * o[1][r]; }
    LDS_FENCE();
#pragma unroll
    for (int k = 0; k < 4; ++k) {
        const int q = 8 * k + (lane >> 3), ch = lane & 7;
        const f32x4v a0 = *(LAS const f32x4v*)(stg + q * 64 + ch * 8), a1 = *(LAS const f32x4v*)(stg + q * 64 + ch * 8 + 4);
        v4u ov; ov.x = cvtpk(a0[0], a0[1]); ov.y = cvtpk(a0[2], a0[3]); ov.z = cvtpk(a1[0], a1[1]); ov.w = cvtpk(a1[2], a1[3]);
        *(v4u*)(base + (size_t)(q >> 2) * s_hi + (q & 3) * s_lo + ch * 8) = ov;
    }
    LDS_FENCE();
}
}
namespace fa {
__device__ __forceinline__ int red8_add(int x) {
    x += __builtin_amdgcn_mov_dpp(x, 0xB1, 0xf, 0xf, true); x += __builtin_amdgcn_mov_dpp(x, 0x4E, 0xf, 0xf, true); x += __builtin_amdgcn_mov_dpp(x, 0x141, 0xf, 0xf, true); return x; }
__device__ __forceinline__ int red8_or(int x) {
    x |= __builtin_amdgcn_mov_dpp(x, 0xB1, 0xf, 0xf, true); x |= __builtin_amdgcn_mov_dpp(x, 0x4E, 0xf, 0xf, true); x |= __builtin_amdgcn_mov_dpp(x, 0x141, 0xf, 0xf, true); return x; }
}
template <int ABL = 0>
__device__ __forceinline__ void ph_nsa_cmp_fast(const Params& p, float* ldsf) {
    using namespace fa;
    LAS char* L = (LAS char*)ldsf;
    constexpr int IMPS = 127;
    const int tid = tid_(), lane = tid & 63, w = __builtin_amdgcn_readfirstlane(tid >> 6), r32 = lane & 31, hi = lane >> 5;
    LAS float* IMP = (LAS float*)(L + 131072 + 16);
    const bf16* QN = (const bf16*)(p.ws + WS_QN); const float* GATES = (const float*)(p.ws + WS_GATES); unsigned* SELM = (unsigned*)(p.ws + WS_SELM);
    bf16* OCB = ABL ? (bf16*)p.out : (bf16*)(p.ws + WS_OCB); if (ABL) SELM = (unsigned*)p.out + (16u << 20);
    const float* gmax = (const float*)(p.ws + WS_GMAX); const float gq = gmax[0], gkc = gmax[1];
    const float M2 = fminf(8.08f * gq * gkc, 40.f) * 1.4426950408889634f;
    f32x16 negM2v;
#pragma unroll
    for (int i = 0; i < 16; ++i) negM2v[i] = -M2;
    const VcuMap vcu_of = vcu_map(p);
    int bh_res = -1;
    for (int u = blockIdx.x; u < 1024; u += gridDim.x) {
        const int u4 = u >> 8, c = vcu_of(u & 255), ci = c & 31;
        const int bh = c >> 5, tl = u4 == 0 ? ci : u4 == 1 ? 63 - ci : u4 == 2 ? 64 + ci : 127 - ci;
        const int b = bh >> 1, hk = bh & 1, t0 = tl * 64, cur = tl;
        const int tkl = 8 * w + (r32 >> 2), tq = t0 + tkl, g = r32 & 3, m = b * T_ + tq;
        bf16x8 qf[4];
#pragma unroll
        for (int d0 = 0; d0 < 4; ++d0) qf[d0] = *(const bf16x8*)(QN + (size_t)m * 512 + (hk * 4 + g) * 64 + 16 * d0 + 8 * hi);
        const float gate = GATES[(size_t)m * 24 + hk * 12 + g * 3 + 0];
        if (bh != bh_res) {
            const bf16* KC = (const bf16*)(p.ws + WS_KCB) + (size_t)bh * 512 * 64; const bf16* VC = (const bf16*)(p.ws + WS_VCB) + (size_t)bh * 512 * 64;
            __syncthreads();
#pragma unroll
            for (int h4 = 0; h4 < 2; ++h4) { KVRegs kq[4];
#pragma unroll
                for (int j = 0; j < 4; ++j) kv_load(kq[j], KC + (size_t)(4 * h4 + j) * 4096, VC + (size_t)(4 * h4 + j) * 4096, 64, 64, tid);
#pragma unroll
                for (int j = 0; j < 4; ++j) kv_store(kq[j], L + (4 * h4 + j) * 8192, L + 65536 + (4 * h4 + j) * 8192, tid); }
            FA_BAR(); bh_res = bh;
        }
        const int nv = tq >= 31 ? (tq - 31) / 16 + 1 : 0;
        const int nvmax = (t0 + 63 - 31) / 16 + 1, ntile = ABL == 2 ? 0 : t0 + 63 >= 31 ? (nvmax + 63) >> 6 : 0;
        const int tw0 = t0 + 8 * w, nvmin = tw0 >= 31 ? (tw0 - 31) / 16 + 1 : 0;
        float l = 0.f, inv = 0.f, hinv = 0.f;
        f32x16 o[2] = {f32x16{}, f32x16{}};
#pragma unroll 1
        for (int pass = 0; pass < 2; ++pass) {
            float prevp = 0.f;
#pragma unroll 1
            for (int j = 0; j < ntile; ++j) { lptr Kb = L + j * 8192; lptr Vb = L + 65536 + j * 8192; BODY_CMP }
            if (pass == 0) { l += shx<32>(l); inv = l > 0.f ? 1.0f / l : 0.f; hinv = 0.5f * inv; }
        }
        {
            const float gcl = gate * inv;
#pragma unroll
            for (int r = 0; r < 16; ++r) {
                const int q0 = (r & 3) + 8 * (r >> 2);
                const float g0 = __builtin_bit_cast(float, __builtin_amdgcn_readlane(__builtin_bit_cast(int, gcl), q0)), g1 = __builtin_bit_cast(float, __builtin_amdgcn_readlane(__builtin_bit_cast(int, gcl), q0 + 4));
                const int q = crow(r, hi), tk = t0 + 8 * w + (q >> 2), gg = q & 3; const float gc = hi ? g1 : g0;
#pragma unroll
                for (int d0 = 0; d0 < 2; ++d0) OCB[(size_t)(b * T_ + tk) * 512 + hk * 256 + gg * 64 + 32 * d0 + r32] = (bf16)f2bf(gc * o[d0][r]);
            }
        }
        LDS_FENCE();
        const int nf = cur + 1 < 3 ? cur + 1 : 3, need = 16 - nf, ncand = cur - 2 > 0 ? cur - 2 : 0;
        if (ABL != 1) {
            const int tk = lane >> 3, sub = lane & 7;
            const LAS float* rowp = IMP + (8 * w + tk) * IMPS;
            unsigned selw[4] = {0u, 0u, 0u, 0u};
            bool conflict = false;
            if (ncand > need) {
                unsigned uu[16];
#pragma unroll
                for (int i = 0; i < 16; ++i) { const int j = sub + 8 * i; uu[i] = (j >= 1 && j <= cur - 2) ? __float_as_uint(rowp[j - 1]) : 0u; }
                unsigned thr = 0u; bool done = false;
#pragma unroll 1
                for (int bit = 30; bit >= 0; --bit) {
                    const unsigned cd = thr | (1u << bit);
                    int cnt = 0;
#pragma unroll
                    for (int i = 0; i < 16; ++i) cnt += (uu[i] >= cd) ? 1 : 0;
                    cnt = red8_add(cnt);
                    thr = (!done && cnt >= need) ? cd : thr; done = done || cnt == need;
                    if (__ballot(!done) == 0ull) break;
                }
                int cg = 0, ce = 0;
#pragma unroll
                for (int i = 0; i < 16; ++i) { const int j = sub + 8 * i; const bool cand = j >= 1 && j <= cur - 2; cg += (uu[i] > thr) ? 1 : 0; ce += (cand && uu[i] == thr) ? 1 : 0; }
                cg = red8_add(cg); ce = red8_add(ce);
                conflict = ce != need - cg;
#pragma unroll
                for (int i = 0; i < 16; ++i) { const int j = sub + 8 * i; const bool cand = j >= 1 && j <= cur - 2; if (uu[i] > thr || (cand && uu[i] == thr)) selw[i >> 2] |= 1u << (sub + 8 * (i & 3)); }
            } else {
#pragma unroll
                for (int i = 0; i < 16; ++i) { const int j = sub + 8 * i; if (j >= 1 && j <= cur - 2) selw[i >> 2] |= 1u << (sub + 8 * (i & 3)); }
            }
#pragma unroll
            for (int i = 0; i < 16; ++i) { const int j = sub + 8 * i; if (j <= cur && (j == 0 || j == cur || j == cur - 1)) selw[i >> 2] |= 1u << (sub + 8 * (i & 3)); }
#pragma unroll
            for (int k = 0; k < 4; ++k) selw[k] = (unsigned)red8_or((int)selw[k]);
            if (sub == 0) { v4u mk; mk.x = selw[0]; mk.y = selw[1]; mk.z = selw[2]; mk.w = selw[3]; *(v4u*)(SELM + ((size_t)bh * T_ + t0 + 8 * w + tk) * 4) = mk; }
            const unsigned long long cmask = __ballot(conflict);
            if (cmask != 0ull) {
                const unsigned long long ltmask = (1ull << lane) - 1ull;
#pragma unroll 1
                for (int t8 = 0; t8 < 8; ++t8) {
                    if (((cmask >> (8 * t8)) & 1ull) == 0ull) continue;
                    const LAS float* row = IMP + (8 * w + t8) * IMPS;
                    const int j0 = lane, j1 = lane + 64;
                    const bool c0 = j0 >= 1 && j0 <= cur - 2, c1 = j1 <= cur - 2;
                    const unsigned u0 = c0 ? __float_as_uint(row[j0 - 1]) : 0u, u1 = c1 ? __float_as_uint(row[j1 - 1]) : 0u;
                    unsigned thr = 0u;
#pragma unroll 1
                    for (int bit = 30; bit >= 0; --bit) {
                        const unsigned cd = thr | (1u << bit);
                        const int cnt = __popcll(__ballot(u0 >= cd)) + __popcll(__ballot(u1 >= cd));
                        if (cnt >= need) thr = cd;
                    }
                    const bool g0 = c0 && u0 > thr, g1 = c1 && u1 > thr, e0 = c0 && u0 == thr, e1 = c1 && u1 == thr;
                    const int rem = need - (__popcll(__ballot(g0)) + __popcll(__ballot(g1)));
                    const unsigned long long b0 = __ballot(e0), b1 = __ballot(e1);
                    bool s0 = g0 || (e0 && __popcll(b0 & ltmask) < rem);
                    bool s1 = g1 || (e1 && __popcll(b0) + __popcll(b1 & ltmask) < rem);
                    s0 = s0 || (j0 <= cur && (j0 == 0 || j0 == cur || j0 == cur - 1));
                    s1 = s1 || (j1 <= cur && (j1 == cur || j1 == cur - 1));
                    const unsigned long long mlo = __ballot(s0), mhi = __ballot(s1);
                    if (lane == 0) { v4u mk; mk.x = (unsigned)mlo; mk.y = (unsigned)(mlo >> 32); mk.z = (unsigned)mhi; mk.w = (unsigned)(mhi >> 32);
                        asm volatile("s_waitcnt vmcnt(0)" ::: "memory");
                        *(v4u*)(SELM + ((size_t)bh * T_ + t0 + 8 * w + t8) * 4) = mk; }
                }
            }
        }
    }
}

#define TOF_SB(n) (ktop - (n))
namespace fa {
template <bool MASK>
__device__ __forceinline__ void sb_tile(f32x16& p0, f32x16& p1, float& Rl, int tq, int kb, int hi) {
    f32x16 l0, l1;
#pragma unroll
    for (int r = 0; r < 16; ++r) {
        float c0 = __builtin_amdgcn_rcpf(1.0f + __builtin_amdgcn_exp2f(p0[r])), c1 = __builtin_amdgcn_rcpf(1.0f + __builtin_amdgcn_exp2f(p1[r]));
        if (MASK) { const int k0 = kb + (r & 3) + 8 * (r >> 2); c0 = k0 < tq ? c0 : 1.0f; c1 = k0 + 32 < tq ? c1 : 1.0f; }
        l0[r] = c0; l1[r] = c1;
    }
    float tot[8], pto[8];
#pragma unroll
    for (int k = 0; k < 8; ++k) { const f32x16& X = (k >> 2) ? l1 : l0; const int r0 = 4 * (k & 3); tot[k] = (X[r0] * X[r0 + 1]) * (X[r0 + 2] * X[r0 + 3]); pto[k] = shx<32>(tot[k]); }
    float above = Rl;
#pragma unroll
    for (int k = 7; k >= 0; --k) {
        f32x16& X = (k >> 2) ? l1 : l0; f32x16& Z = (k >> 2) ? p1 : p0; const int r0 = 4 * (k & 3);
        const float ab = hi == 0 ? above * pto[k] : above;
        const float x3 = X[r0 + 3], x2 = X[r0 + 2], x1 = X[r0 + 1], x0 = X[r0];
        const float f3 = ab, f2 = f3 * x3, f1 = f2 * x2, f0 = f1 * x1;
        Z[r0 + 3] = f3 - f3 * x3; Z[r0 + 2] = f2 - f2 * x2; Z[r0 + 1] = f1 - f1 * x1; Z[r0] = f0 - f0 * x0;
        above *= tot[k] * pto[k];
    }
    Rl = above;
}
}
#define BODY_SB \
{ \
            int alld = 1; \
_Pragma("unroll") \
            for (int i = 0; i < 8; ++i) alld &= flags[((it - 1) & 1) * 8 + i]; \
            if (alld) { stop_ = true; } \
            else { \
            const int kt = j; \
            if (!done && 64 * kt <= trow + 30) { \
                f32x16 p0, p1; qk_tile(p0, p1, Kb, qf, r32, hi); \
                const int kb = 64 * kt + 4 * hi; \
                if (64 * kt + 63 >= trow) sb_tile<true>(p0, p1, R, tq, kb, hi); else sb_tile<false>(p0, p1, R, tq, kb, hi); \
                v4u pw[4]; pack_p(pw, p0, p1); \
                pv_tile(o, Vb, pw, lane, hi); \
                done = __all(R < 8.5e-27f) || kt == 0; \
            } \
            if (lane == 0) flags[(it & 1) * 8 + w] = done ? 1 : 0; \
        } }
__device__ __forceinline__ void ph_sb_fast(const Params& p, float* ldsf) {
    using namespace fa;
    LAS char* L = (LAS char*)ldsf;
    const int tid = tid_(), lane = tid & 63, w = __builtin_amdgcn_readfirstlane(tid >> 6), r32 = lane & 31, hi = lane >> 5, hsel = w >> 2;
    volatile LAS int* flags = (volatile LAS int*)(L + 65536);
    const bf16* QS = (const bf16*)(p.ws + WS_QS); bf16* MIX = (bf16*)(p.ws + WS_MIX);
    int it = 0;
    unsigned* qhead = (unsigned*)(p.ws + WS_CTL) + CW_SBQ;
    for (;;) {
        if (tid == 0) flags[16] = (int)__hip_atomic_fetch_add(qhead, 1u, __ATOMIC_RELAXED, __HIP_MEMORY_SCOPE_AGENT);
        FA_BAR();
        const int u = flags[16];
        if (u >= 1024) break;
        const int bhp = u >> 6, tl = u & 63, b = bhp >> 2, hp = bhp & 3, t0 = tl * 128, h = 2 * hp + hsel, trow = t0 + 32 * (w & 3);
        const bf16* Kg0 = (const bf16*)(p.ws + WS_KSB) + (size_t)(b * 8 + 2 * hp) * T_ * 64; const bf16* Vg0 = (const bf16*)(p.ws + WS_VSB) + (size_t)(b * 8 + 2 * hp) * T_ * 64;
        const int tq = trow + r32, m = b * T_ + tq;
        bf16x8 qf[4];
#pragma unroll
        for (int d0 = 0; d0 < 4; ++d0) qf[d0] = *(const bf16x8*)(QS + (size_t)m * 512 + h * 64 + 16 * d0 + 8 * hi);
        f32x16 o[2] = {f32x16{}, f32x16{}};
        float R = 1.0f; bool done = false;
        const int ktop = (t0 + 126) >> 6, cnt = ktop + 1;
        if (lane == 0) { flags[w] = 0; flags[8 + w] = 0; }
        {
            KVRegs kq[2][2]; bool stop_ = false;
#pragma unroll
            for (int k_ = 0; k_ < 2; ++k_) if (k_ < cnt) { const int jj = ktop - k_;
#pragma unroll
                for (int hh = 0; hh < 2; ++hh) kv_load(kq[k_][hh], Kg0 + (size_t)hh * T_ * 64 + (size_t)jj * 4096, Vg0 + (size_t)hh * T_ * 64 + (size_t)jj * 4096, 64, 64, tid); }
#pragma unroll 1
            for (int n_ = 0; n_ < cnt && !stop_; n_ += 2) {
#pragma unroll
                for (int k_ = 0; k_ < 2; ++k_) { if (n_ + k_ < cnt && !stop_) {
                    const int j = ktop - (n_ + k_);
                    LAS char* Sb = L + (it & 1) * 32768; ++it;
#pragma unroll
                    for (int hh = 0; hh < 2; ++hh) kv_store(kq[k_][hh], Sb + hh * 16384, Sb + hh * 16384 + 8192, tid);
                    FA_BAR();
                    if (n_ + k_ + 2 < cnt) { const int jn = ktop - (n_ + k_ + 2);
#pragma unroll
                        for (int hh = 0; hh < 2; ++hh) kv_load(kq[k_][hh], Kg0 + (size_t)hh * T_ * 64 + (size_t)jn * 4096, Vg0 + (size_t)hh * T_ * 64 + (size_t)jn * 4096, 64, 64, tid); }
                    LAS char* Kb = Sb + hsel * 16384; LAS char* Vb = Kb + 8192;
                    BODY_SB
                } }
            }
        }
#pragma unroll
        for (int r = 0; r < 16; ++r) {
            const size_t mo = (size_t)(b * T_ + trow + crow(r, hi));
#pragma unroll
            for (int d0 = 0; d0 < 2; ++d0) MIX[mo * D_ + 512 + h * 64 + 32 * d0 + r32] = (bf16)f2bf(o[d0][r]);
        }
        FA_BAR();
    }
}

#define BODY_MEM \
{ \
            f32x16 p0, p1; qk_tile(p0, p1, Kb, qf, r32, hi); \
            float ls = 0.f; \
_Pragma("unroll") \
            for (int r = 0; r < 16; ++r) { const float e0 = __builtin_amdgcn_exp2f(p0[r] - M2), e1 = __builtin_amdgcn_exp2f(p1[r] - M2); p0[r] = e0; p1[r] = e1; ls += e0 + e1; } \
            l += ls; \
            v4u pw[4]; pack_p(pw, p0, p1); \
            pv_tile(o, Vb, pw, lane, hi); \
        }
__device__ __forceinline__ void ph_memattn_fast(const Params& p, float* ldsf) {
    using namespace fa;
    LAS char* L = (LAS char*)ldsf;
    const int tid = tid_(), lane = tid & 63, w = __builtin_amdgcn_readfirstlane(tid >> 6), r32 = lane & 31, hi = lane >> 5;
    LAS float* wsf = (LAS float*)(L + 32768) + w * 64;
    const bf16* QM = (const bf16*)(p.ws + WS_QMEM); bf16* OM = (bf16*)(p.ws + WS_OMEM);
    const float* gmax = (const float*)(p.ws + WS_GMAX); const float M2 = fminf(8.08f * gmax[4] * gmax[5], 40.f) * 1.4426950408889634f;
    int it = 0;
    for (int u = blockIdx.x; u < 512; u += gridDim.x) {
        const int tl = u & 31, h = (u >> 5) & 3, b = u >> 7, t0 = tl * 256;
        const bf16* Kg = (const bf16*)(p.ws + WS_KMEM) + (size_t)b * MEM_ * 256 + h * 64; const bf16* Vg = (const bf16*)(p.ws + WS_VMEM) + (size_t)b * MEM_ * 256 + h * 64;
        const int m = b * T_ + t0 + 32 * w + r32;
        bf16x8 qf[4];
#pragma unroll
        for (int d0 = 0; d0 < 4; ++d0) qf[d0] = *(const bf16x8*)(QM + (size_t)m * 256 + h * 64 + 16 * d0 + 8 * hi);
        f32x16 o[2] = {f32x16{}, f32x16{}}; float l = 0.f;
        KV_PIPE_D(4, 4, TOF_ID, Kg, Vg, 256, 256, 64 * 256, 64 * 256, BODY_MEM);
        l += shx<32>(l);
        LDS_FENCE();
        if (hi == 0) wsf[r32] = 1.0f / l;
        LDS_FENCE();
        store_tile_bf16((LAS float*)(L + 36864) + w * 2048, o, wsf, lane, r32, hi, OM + (size_t)(b * T_ + t0 + 32 * w) * 256 + h * 64, 4 * 256, 256);
    }
}

namespace fa {
__device__ __forceinline__ void qk_tile_m(f32x16& p0, f32x16& p1, lptr Kb, const bf16x8 (&qf)[4], int r32, int hi, const f32x16& negm) {
    lptr kb = Kb + hi * 1024;
    f32x16 a, b;
#pragma unroll
    for (int d0 = 0; d0 < 4; ++d0) {
        const int ko = (r32 ^ (2 * d0 + hi)) * 16;
        const bf16x8 b0 = *(LAS const bf16x8*)(kb + d0 * 2048 + ko), b1 = *(LAS const bf16x8*)(kb + d0 * 2048 + 512 + ko);
        if (d0 == 0) { a = __builtin_amdgcn_mfma_f32_32x32x16_bf16(b0, qf[0], negm, 0, 0, 0); b = __builtin_amdgcn_mfma_f32_32x32x16_bf16(b1, qf[0], negm, 0, 0, 0); }
        else { a = __builtin_amdgcn_mfma_f32_32x32x16_bf16(b0, qf[d0], a, 0, 0, 0); b = __builtin_amdgcn_mfma_f32_32x32x16_bf16(b1, qf[d0], b, 0, 0, 0); }
    }
    p0 = a; p1 = b;
}
template <bool CMP, bool WIN>
__device__ __forceinline__ float softmax_tile(f32x16& p0, f32x16& p1, bool lanebit, int kb, int tq) {
    float ls = 0.f;
#pragma unroll
    for (int r = 0; r < 16; ++r) {
        float e0 = __builtin_amdgcn_exp2f(p0[r]), e1 = __builtin_amdgcn_exp2f(p1[r]);
        if (CMP) { const int k0 = kb + (r & 3) + 8 * (r >> 2), k1 = k0 + 32; e0 = (k0 <= tq && (!WIN || tq - k0 < 512)) ? e0 : 0.f; e1 = (k1 <= tq && (!WIN || tq - k1 < 512)) ? e1 : 0.f; }
        p0[r] = e0; p1[r] = e1; ls += e0 + e1;
    }
    return lanebit ? ls : 0.f;
}
}
#define SW5_TILE(PA0, PA1, J, SLOT) do { \
    const int kb_ = 64 * (J) + 4 * hi; \
    const bool lb_ = BR ? true : ((((J) < 64 ? mlo : mhi) >> ((J) & 63)) & 1ull) != 0ull; \
    const bool cmp_ = BR ? ((J) == cur || (J) + 8 == cur) : ((J) == cur); \
    if (cmp_) (void)softmax_tile<true, BR != 0>(PA0, PA1, lb_, kb_, tq); else (void)softmax_tile<false, BR != 0>(PA0, PA1, lb_, kb_, tq); \
    v4u pw_[4]; pack_p(pw_, PA0, PA1); \
    if (!BR) { _Pragma("unroll") for (int s_ = 0; s_ < 4; ++s_) { pw_[s_].x = lb_ ? pw_[s_].x : 0u; pw_[s_].y = lb_ ? pw_[s_].y : 0u; pw_[s_].z = lb_ ? pw_[s_].z : 0u; pw_[s_].w = lb_ ? pw_[s_].w : 0u; } } \
    { const bf16x8 ones_ = {0x3F80, 0x3F80, 0x3F80, 0x3F80, 0x3F80, 0x3F80, 0x3F80, 0x3F80};        \
      _Pragma("unroll") for (int s_ = 0; s_ < 4; ++s_) lacc = __builtin_amdgcn_mfma_f32_32x32x16_bf16(__builtin_bit_cast(bf16x8, pw_[s_]), ones_, lacc, 0, 0, 0); } \
    pv_tile(o, (SLOT) + 8192, pw_, lane, hi); } while (0)
namespace fa {
__device__ __forceinline__ void kv_dma(const bf16* Kg, const bf16* Vg, LAS char* Sl, int w, int lane) {
    __builtin_amdgcn_global_load_lds((const unsigned*)(Kg + (size_t)(lane ^ w) * 64 + w * 8), (LAS unsigned*)(Sl + w * 1024), 16, 0, 0);
    __builtin_amdgcn_global_load_lds((const unsigned*)(Vg + (size_t)(16 * (w & 3) + (lane >> 2)) * 64 + (w >> 2) * 32 + (((lane & 3) * 8) ^ (((lane >> 4) & 1) << 4))), (LAS unsigned*)(Sl + 8192 + w * 1024), 16, 0, 0);
}
#define FA_BAR_VM0() do { asm volatile("s_waitcnt vmcnt(0) lgkmcnt(0)" ::: "memory"); __builtin_amdgcn_s_barrier(); asm volatile("" ::: "memory"); } while (0)
}
template <int BR, bool PIPE = true>
__device__ __forceinline__ void sw6_branch(fa::f32x16 (&o)[2], fa::f32x16& lacc, LAS char* L, int& it, const bf16* Kg, const bf16* Vg, const fa::bf16x8 (&qf)[4], unsigned long long mlo, unsigned long long mhi,
                                           int cur, int tq, float negM2s, int w, int lane, int r32, int hi, unsigned long long wlo, unsigned long long whi) {
    using namespace fa;
    f32x16 negM2;
#pragma unroll
    for (int r = 0; r < 16; ++r) negM2[r] = negM2s;
    asm volatile("" : "+v"(negM2));
    const int j0 = BR ? (cur >= 8 ? cur - 8 : 0) : 0;
    {   LAS char* S0 = L + (it & 1) * 32768;
        kv_dma(Kg + (size_t)j0 * 4096, Vg + (size_t)j0 * 4096, S0, w, lane);
        if (j0 + 1 <= cur) kv_dma(Kg + (size_t)(j0 + 1) * 4096, Vg + (size_t)(j0 + 1) * 4096, S0 + 16384, w, lane); }
#pragma unroll 1
    for (int base = j0; base <= cur; base += 2, ++it) {
        const bool two = base + 1 <= cur;
        LAS char* S0 = L + (it & 1) * 32768; LAS char* S1 = L + ((it + 1) & 1) * 32768;
        FA_BAR_VM0();
        if (base + 2 <= cur) kv_dma(Kg + (size_t)(base + 2) * 4096, Vg + (size_t)(base + 2) * 4096, S1, w, lane);
        if (base + 3 <= cur) kv_dma(Kg + (size_t)(base + 3) * 4096, Vg + (size_t)(base + 3) * 4096, S1 + 16384, w, lane);
        if (PIPE) {
            f32x16 pa0, pa1; qk_tile_m(pa0, pa1, S0, qf, r32, hi, negM2);
            if (two) {
                f32x16 pb0, pb1; qk_tile_m(pb0, pb1, S0 + 16384, qf, r32, hi, negM2);
                SW5_TILE(pa0, pa1, base, S0);
                SW5_TILE(pb0, pb1, base + 1, S0 + 16384);
            } else {
                SW5_TILE(pa0, pa1, base, S0);
            }
        } else {
#pragma unroll 1
            for (int i = 0; i < (two ? 2 : 1); ++i) {
                LAS char* Sl = S0 + i * 16384; const int jj = base + i;
                f32x16 pa0, pa1; qk_tile_m(pa0, pa1, Sl, qf, r32, hi, negM2);
                SW5_TILE(pa0, pa1, jj, Sl);
            }
        }
    }
}

template <int BR>
__device__ __forceinline__ void sw8_branch(fa::f32x16 (&o)[2], fa::f32x16& lacc, LAS char* L, int& it, const bf16* Kg, const bf16* Vg, const fa::bf16x8 (&qf)[4], unsigned long long mlo, unsigned long long mhi,
                                           int cur, int tq, float negM2s, int w, int lane, int r32, int hi, unsigned long long wlo, unsigned long long whi) {
    using namespace fa;
    f32x16 negM2;
#pragma unroll
    for (int r = 0; r < 16; ++r) negM2[r] = negM2s;
    asm volatile("" : "+v"(negM2));
    const int j0 = BR ? (cur >= 8 ? cur - 8 : 0) : 0;
    {   LAS char* S0 = L + (it & 1) * 65536;
#pragma unroll
        for (int i = 0; i < 4; ++i) if (j0 + i <= cur) kv_dma(Kg + (size_t)(j0 + i) * 4096, Vg + (size_t)(j0 + i) * 4096, S0 + i * 16384, w, lane); }
#pragma unroll 1
    for (int base = j0; base <= cur; base += 4, ++it) {
        LAS char* S0 = L + (it & 1) * 65536; LAS char* S1 = L + ((it + 1) & 1) * 65536;
        FA_BAR_VM0();
#pragma unroll
        for (int i = 0; i < 4; ++i) if (base + 4 + i <= cur) kv_dma(Kg + (size_t)(base + 4 + i) * 4096, Vg + (size_t)(base + 4 + i) * 4096, S1 + i * 16384, w, lane);
        const int ni = cur - base + 1 < 4 ? cur - base + 1 : 4;
#pragma unroll 1
        for (int i = 0; i < ni; ++i) {
            LAS char* Sl = S0 + i * 16384; const int jj = base + i;
            if (!BR && (((jj < 64 ? wlo : whi) >> (jj & 63)) & 1ull) == 0ull) continue;
            f32x16 pa0, pa1; qk_tile_m(pa0, pa1, Sl, qf, r32, hi, negM2);
            SW5_TILE(pa0, pa1, jj, Sl);
        }
    }
}

__device__ __forceinline__ void ph_nsa_selwin6(const Params& p, float* ldsf) {
    using namespace fa;
    LAS char* L = (LAS char*)ldsf;
    constexpr int OFF_WSF = 131072, OFF_STG = 65536;
    const int tid = tid_(), lane = tid & 63, w = __builtin_amdgcn_readfirstlane(tid >> 6), r32 = lane & 31, hi = lane >> 5;
    LAS float* wsf = (LAS float*)(L + OFF_WSF) + w * 64;
    const bf16* QN = (const bf16*)(p.ws + WS_QN); const float* GATES = (const float*)(p.ws + WS_GATES); const unsigned* SELM = (const unsigned*)(p.ws + WS_SELM);
    const bf16* OCB = (const bf16*)(p.ws + WS_OCB); bf16* MIX = (bf16*)(p.ws + WS_MIX);
    const float* gmax = (const float*)(p.ws + WS_GMAX); const float gq = gmax[0], gks = gmax[2], gkw = gmax[3];
    const float M2s = fminf(8.08f * gq * gks, 40.f) * 1.4426950408889634f, M2w = fminf(8.08f * gq * gkw, 40.f) * 1.4426950408889634f;
    const VcuMap vcu_of = vcu_map(p);
    for (int u = blockIdx.x; u < 1024; u += gridDim.x) {
        const int u4 = u >> 8, c = vcu_of(u & 255), ci = c & 31;
        const int bh = c >> 5, tl = u4 == 0 ? ci : u4 == 1 ? 63 - ci : u4 == 2 ? 64 + ci : 127 - ci;
        const int b = bh >> 1, hk = bh & 1, t0 = tl * 64, cur = tl;
        const int tq = t0 + 8 * w + (r32 >> 2), g = r32 & 3, m = b * T_ + tq;
        bf16x8 qf[4];
#pragma unroll
        for (int d0 = 0; d0 < 4; ++d0) qf[d0] = *(const bf16x8*)(QN + (size_t)m * 512 + (hk * 4 + g) * 64 + 16 * d0 + 8 * hi);
        const v4u mk = *(const v4u*)(SELM + ((size_t)bh * T_ + tq) * 4);
        const unsigned long long mlo = (unsigned long long)mk.x | ((unsigned long long)mk.y << 32), mhi = (unsigned long long)mk.z | ((unsigned long long)mk.w << 32);
        const unsigned long long wlo = (unsigned long long)wave_or(mk.x) | ((unsigned long long)wave_or(mk.y) << 32), whi = (unsigned long long)wave_or(mk.z) | ((unsigned long long)wave_or(mk.w) << 32);
        LAS float* stg = (LAS float*)(L + OFF_STG + w * 8192);
        __syncthreads();
        int it = 0;
        {
            f32x16 o[2] = {f32x16{}, f32x16{}}; f32x16 lacc = f32x16{};
            sw8_branch<0>(o, lacc, L, it, (const bf16*)(p.ws + WS_KS) + (size_t)bh * T_ * 64, (const bf16*)(p.ws + WS_VS) + (size_t)bh * T_ * 64, qf, mlo, mhi, cur, tq, -M2s, w, lane, r32, hi, wlo, whi);
            LDS_FENCE(); if (hi == 0) wsf[r32] = GATES[(size_t)m * 24 + hk * 12 + g * 3 + 1]; LDS_FENCE();
            __syncthreads();
#pragma unroll
            for (int r = 0; r < 16; ++r) { const int q = crow(r, hi); const float fr = wsf[q] * __builtin_amdgcn_rcpf(fmaxf(lacc[r], 1e-30f)); stg[q * 64 + r32] = fr * o[0][r]; stg[q * 64 + 32 + r32] = fr * o[1][r]; }
        }
        {
            f32x16 o[2] = {f32x16{}, f32x16{}}; f32x16 lacc = f32x16{};
            int itw = 0;
            sw6_branch<1, false>(o, lacc, L, itw, (const bf16*)(p.ws + WS_KW) + (size_t)bh * T_ * 64, (const bf16*)(p.ws + WS_VW) + (size_t)bh * T_ * 64, qf, mlo, mhi, cur, tq, -M2w, w, lane, r32, hi, 0ull, 0ull);
            LDS_FENCE(); if (hi == 0) wsf[r32] = GATES[(size_t)m * 24 + hk * 12 + g * 3 + 2]; LDS_FENCE();
#pragma unroll
            for (int r = 0; r < 16; ++r) { const int q = crow(r, hi); const float fr = wsf[q] * __builtin_amdgcn_rcpf(fmaxf(lacc[r], 1e-30f)); stg[q * 64 + r32] += fr * o[0][r]; stg[q * 64 + 32 + r32] += fr * o[1][r]; }
        }
        {
            LDS_FENCE();
#pragma unroll
            for (int k = 0; k < 4; ++k) {
                const int q = 8 * k + (lane >> 3), ch = lane & 7;
                const size_t mo = (size_t)(b * T_ + t0 + 8 * w + (q >> 2)); const int col = hk * 256 + (q & 3) * 64 + ch * 8;
                const f32x4v a0 = *(LAS const f32x4v*)(stg + q * 64 + ch * 8), a1 = *(LAS const f32x4v*)(stg + q * 64 + ch * 8 + 4);
                const v4u oc = *(const v4u*)(OCB + mo * 512 + col);
                v4u ov;
                ov.x = cvtpk(a0[0] + bf2f((bf16)(oc.x & 0xffffu)), a0[1] + bf2f((bf16)(oc.x >> 16)));
                ov.y = cvtpk(a0[2] + bf2f((bf16)(oc.y & 0xffffu)), a0[3] + bf2f((bf16)(oc.y >> 16)));
                ov.z = cvtpk(a1[0] + bf2f((bf16)(oc.z & 0xffffu)), a1[1] + bf2f((bf16)(oc.z >> 16)));
                ov.w = cvtpk(a1[2] + bf2f((bf16)(oc.w & 0xffffu)), a1[3] + bf2f((bf16)(oc.w >> 16)));
                *(v4u*)(MIX + mo * D_ + col) = ov;
            }
            LDS_FENCE();
        }
    }
}


#define LDS3 ((LAS unsigned char*)lds)
__device__ __forceinline__ void ph_gemm_gu(float* lds, const bf16* XN, const bf16* Wgu, bf16* ACT, const float* rowsq) {
    pg8::Gemm g{XN, Wgu, NT, 2 * FF, D_, D_}; pg8::StaticOrder S; S.init(NT, 2 * FF, gridDim.x, blockIdx.x);
    pg8::EpiSwiglu E{ACT, FF, rowsq};
    pg8::gemm_phase<pg8::EpiSwiglu, pg8::StaticOrder, true, true>(LDS3, g, S, E);
}
template <bool NORM, int RS, bool HALFSTEP, bool BASEBF, bool OUTF32>
__device__ __forceinline__ void ph_gemm_resid(float* lds, const bf16* A, const bf16* Bt, int K, const float* base, float* out, unsigned char* ws, const float* g1 = nullptr) {
    pg8::Gemm g{A, Bt, NT, D_, K, K}; pg8::StaticOrder S; S.init(NT, D_, gridDim.x, blockIdx.x);
    pg8::EpiResid<NORM, RS, HALFSTEP, BASEBF, OUTF32> E{base, out, ws, g1};
    pg8::gemm_phase<pg8::EpiResid<NORM, RS, HALFSTEP, BASEBF, OUTF32>, pg8::StaticOrder, true, true>(LDS3, g, S, E);
}
__device__ __forceinline__ void ph_gemm_win(const Params& p, float* lds) {
    pg8::Gemm g{(const bf16*)(p.ws + WS_XN), (const bf16*)(p.ws + WS_WIN), NT, INP, D_, D_}; pg8::StaticOrder S; S.init(NT, INP, gridDim.x, blockIdx.x);
    pg8::EpiWin E{p.ws, (const float*)(p.ws + WS_ROWSQ)};
    pg8::gemm_phase<pg8::EpiWin, pg8::StaticOrder, true, true>(LDS3, g, S, E);
}
__device__ __forceinline__ void cmp2_panel(const Params& p, int kv, int pm) {
    using namespace fa;
    const int tid = tid_(), lane = tid & 63, w = __builtin_amdgcn_readfirstlane(tid >> 6), r32 = lane & 31, hi = lane >> 5;
    const int row = 256 * pm + 32 * w + r32;
    const bf16* hrow = (const bf16*)(p.ws + WS_HC) + ((size_t)kv * 4096 + row) * 256;
    const bf16* w2t = (const bf16*)(p.ws + WS_W2T) + (size_t)kv * 64 * 256;
    f32x16 acc[2] = {f32x16{}, f32x16{}};
#pragma unroll 4
    for (int ks = 0; ks < 16; ++ks) {
        const bf16x8 hb = *(const bf16x8*)(hrow + 16 * ks + 8 * hi);
#pragma unroll
        for (int blk = 0; blk < 2; ++blk) { const bf16x8 wa = *(const bf16x8*)(w2t + (size_t)(32 * blk + r32) * 256 + 16 * ks + 8 * hi);
            acc[blk] = __builtin_amdgcn_mfma_f32_32x32x16_bf16(wa, hb, acc[blk], 0, 0, 0); }
    }
    const int bh = row >> 9, n = row & 511, b = bh >> 1;
    if (n >= NCMP) return;
    if (kv) {
        bf16* dst = (bf16*)(p.ws + WS_VCB) + ((size_t)bh * 512 + n) * 64;
#pragma unroll
        for (int blk = 0; blk < 2; ++blk)
#pragma unroll
            for (int rq = 0; rq < 4; ++rq) { v2u q; q.x = cvtpk(acc[blk][4 * rq], acc[blk][4 * rq + 1]); q.y = cvtpk(acc[blk][4 * rq + 2], acc[blk][4 * rq + 3]); *(v2u*)(dst + 32 * blk + 8 * rq + 4 * hi) = q; }
        return;
    }
    float ss = 0.f;
#pragma unroll
    for (int blk = 0; blk < 2; ++blk)
#pragma unroll
        for (int r = 0; r < 16; ++r) ss += acc[blk][r] * acc[blk][r];
    ss += shx<32>(ss);
    const float rr = rsqrtf(ss * (1.f / 64.f) + EPS);
    const float* g = p.in[10];
#pragma unroll
    for (int blk = 0; blk < 2; ++blk)
#pragma unroll
        for (int rq = 0; rq < 4; ++rq) { const f32x4v gg = *(const f32x4v*)(g + 32 * blk + 8 * rq + 4 * hi);
#pragma unroll
            for (int i = 0; i < 4; ++i) acc[blk][4 * rq + i] *= rr * gg[i]; }
    {
        const int m = b * T_ + 16 * n + 31;
        const f32x4v c4 = *(const f32x4v*)((const float*)(p.ws + WS_ROPEC) + (size_t)m * 8 + 4 * hi), s4 = *(const f32x4v*)((const float*)(p.ws + WS_ROPES) + (size_t)m * 8 + 4 * hi);
#pragma unroll
        for (int i = 0; i < 4; ++i) { const float y0 = acc[0][i], y1 = acc[0][4 + i]; acc[0][i] = y0 * c4[i] - y1 * s4[i]; acc[0][4 + i] = y1 * c4[i] + y0 * s4[i]; }
    }
    bf16* dst = (bf16*)(p.ws + WS_KCB) + ((size_t)bh * 512 + n) * 64;
#pragma unroll
    for (int blk = 0; blk < 2; ++blk)
#pragma unroll
        for (int rq = 0; rq < 4; ++rq) { v2u q; q.x = cvtpk(acc[blk][4 * rq], acc[blk][4 * rq + 1]); q.y = cvtpk(acc[blk][4 * rq + 2], acc[blk][4 * rq + 3]); *(v2u*)(dst + 32 * blk + 8 * rq + 4 * hi) = q; }
}
__device__ __forceinline__ void ph_gemm_cmp1(const Params& p, float* lds) {
    float* biasw = (float*)(p.ws + WS_BIASW) + (size_t)(blockIdx.x & 31) * 256;
    if (blockIdx.x < 32) {
        const int j = tid_();
        if (j < 256) { const float* part = (const float*)(p.ws + WS_BIASP) + (blockIdx.x >= 16 ? 256 : 0) + j; float a = 0.f;
#pragma unroll
            for (int b = 0; b < 64; ++b) a += part[b * 512];
            biasw[j] = a; }
        asm volatile("s_waitcnt vmcnt(0)" ::: "memory"); __syncthreads();
    }
    {   pg8::Gemm g{(const bf16*)(p.ws + WS_KCR), (const bf16*)(p.ws + WS_WC1K), 4096, 256, 2048, 1024}; pg8::OffsetOrder S{(int)blockIdx.x, 0, 16, 1};
        pg8::EpiCmp1 E{(bf16*)(p.ws + WS_HC), biasw};
        pg8::gemm_phase<pg8::EpiCmp1, pg8::OffsetOrder, true, true>(LDS3, g, S, E);
        if ((int)blockIdx.x < 16) { __syncthreads(); cmp2_panel(p, 0, (int)blockIdx.x); } }
    {   pg8::Gemm g{(const bf16*)(p.ws + WS_VCR), (const bf16*)(p.ws + WS_WC1V), 4096, 256, 2048, 1024}; pg8::OffsetOrder S{(int)blockIdx.x, 16, 16, 1};
        pg8::EpiCmp1 E{(bf16*)(p.ws + WS_HC) + (size_t)4096 * 256, biasw};
        pg8::gemm_phase<pg8::EpiCmp1, pg8::OffsetOrder, true, true>(LDS3, g, S, E);
        if ((int)blockIdx.x >= 16 && (int)blockIdx.x < 32) { __syncthreads(); cmp2_panel(p, 1, (int)blockIdx.x - 16); } }
}
__device__ __forceinline__ void ph_gemm_memq(const Params& p, float* lds) {
    {   pg8::Gemm g{(const bf16*)(p.ws + WS_XN), (const bf16*)(p.ws + WS_WMQ), NT, 256, D_, D_}; pg8::StaticOrder S; S.init(NT, 256, gridDim.x, blockIdx.x);
        pg8::EpiHeadNorm E{(bf16*)(p.ws + WS_QMEM), nullptr, p.in[25], Q_SCALE, (const float*)(p.ws + WS_ROWSQ) + NT};
        pg8::gemm_phase<pg8::EpiHeadNorm, pg8::StaticOrder, true, true>(LDS3, g, S, E); }
    {   pg8::Gemm g{(const bf16*)(p.ws + WS_XN) + (size_t)NT * D_, (const bf16*)(p.ws + WS_WMKV), NMEM, 512, D_, D_}; pg8::OffsetOrder S{(int)blockIdx.x, 128, 4, 2};
        pg8::EpiHeadNorm E{(bf16*)(p.ws + WS_KMEM), (bf16*)(p.ws + WS_VMEM), p.in[26], 1.0f, nullptr};
        pg8::gemm_phase<pg8::EpiHeadNorm, pg8::OffsetOrder, true, true>(LDS3, g, S, E); }
}

#ifndef PROBE_ABL
#define PROBE_ABL 2
#endif
constexpr int NPH = 19;
__device__ __forceinline__ void run_phase(const Params& p, float* lds, int ph) {
    unsigned char* ws = p.ws;
    switch (ph) {
    case 0: ph_prologue(p, LDS3); break;
    case 1: ph_gemm_gu(lds, (const bf16*)(ws + WS_XN), (const bf16*)(ws + WS_WGU1), (bf16*)(ws + WS_ACT), nullptr); break;
    case 2: ph_gemm_resid<true, 0, true, false, false>(lds, (const bf16*)(ws + WS_ACT), (const bf16*)(ws + WS_WD1), FF, p.in[0], p.out, ws, p.in[3]); break;
    case 4: ph_gemm_win(p, lds); break;
    case 5: ph_gemm_cmp1(p, lds); ph_sb_fast(p, lds); break;
    case 7: ph_nsa_cmp_fast<0>(p, lds); break;
    case 8: ph_nsa_selwin6(p, lds); break;
    case 11: ph_gemm_resid<true, 1, false, true, false>(lds, (const bf16*)(ws + WS_MIX), (const bf16*)(ws + WS_WOUT), D_, p.out, p.out, ws); break;
    case 13: ph_gemm_memq(p, lds); if (gridDim.x > 136u) ph_conv_ffn2(p, LDS3, 136, (int)gridDim.x - 136); else { __syncthreads(); ph_conv_ffn2(p, LDS3, 0, (int)gridDim.x); } break;
    case 14: ph_memattn_fast(p, lds); break;
    case 15: ph_gemm_resid<true, 2, false, true, false>(lds, (const bf16*)(ws + WS_OMEM), (const bf16*)(ws + WS_WMO), 256, p.out, p.out, ws); break;
    case 17: ph_gemm_gu(lds, (const bf16*)(ws + WS_XN), (const bf16*)(ws + WS_WGU2), (bf16*)(ws + WS_ACT), (const float*)(ws + WS_ROWSQ) + 2 * NT); break;
    case 18: ph_gemm_resid<false, 0, true, true, true>(lds, (const bf16*)(ws + WS_ACT), (const bf16*)(ws + WS_WD2), FF, p.out, p.out, ws); break;
    default: break;
    }
}
#ifndef PROBE_MASK
#define PROBE_MASK 0u
#endif
typedef const __attribute__((address_space(4))) Params* KargPtr;
#if defined(__HIP_DEVICE_COMPILE__)
#define PHASE(i) do { KargPtr pp = (KargPtr)__builtin_amdgcn_kernarg_segment_ptr(); asm volatile("" : "+s"(pp)); Params q; _Pragma("unroll") for (int k_ = 0; k_ < 32; ++k_) q.in[k_] = pp->in[k_]; q.pos = pp->pos; q.out = pp->out; q.ws = pp->ws; run_phase(q, lds, i); } while (0)
#else
#define PHASE(i) do { run_phase(p, lds, i); } while (0)
#endif
constexpr int LDS_BYTES = 163840, LDS_BARST = LDS_BYTES - 64;
__global__ void __launch_bounds__(NTHR, 2) mega(Params p) {
    extern __shared__ __attribute__((aligned(16))) float lds[];
    volatile LAS unsigned* barst = (volatile LAS unsigned*)((LAS unsigned char*)lds + LDS_BARST);
    if (tid_() < 16) barst[tid_()] = 0u;
    __syncthreads();
    XcdBarrier bar = xcd_barrier_post((unsigned*)(p.ws + WS_CTL), barst);
    if (tid_() == 0) {
        unsigned* ctl = (unsigned*)(p.ws + WS_CTL); const unsigned x = xb_xcc_id() & 7u;
        const unsigned rank = __hip_atomic_fetch_add(ctl + CW_XRANK + 64 * x, 1u, __ATOMIC_RELAXED, __HIP_MEMORY_SCOPE_AGENT);
        if (blockIdx.x < 256) __hip_atomic_store(ctl + CW_VCU + blockIdx.x, x * 32u + (rank & 31u), __ATOMIC_RELAXED, __HIP_MEMORY_SCOPE_AGENT);
    }
#define SEAM() xcd_barrier(bar)
    if (p.ws == nullptr) __builtin_amdgcn_s_sleep(1);
    PHASE(0); SEAM();
    PHASE(1); SEAM();
    PHASE(2); SEAM();
    PHASE(4); SEAM();
    PHASE(5); SEAM();
    PHASE(7);
    asm volatile("s_waitcnt vmcnt(0)" ::: "memory"); __syncthreads();
    PHASE(8); SEAM();
    PHASE(11); SEAM();
    PHASE(13); SEAM();
    PHASE(14); SEAM();
    PHASE(15); SEAM();
    PHASE(17); SEAM();
    PHASE(18);
#undef SEAM
}

extern "C" void kernel_launch(void* const* d_in, const int* in_sizes, int n_in, void* d_out, int out_size, void* d_ws, size_t ws_size, hipStream_t stream) {
    if (n_in != 32 || ws_size < WS_NEED) { fprintf(stderr, "kernel_launch: unexpected n_in %d or ws_size %zu (need %zu)\n", n_in, ws_size, (size_t)WS_NEED); return; }
    Params p{};
    for (int i = 0; i < 32; ++i) p.in[i] = (const float*)d_in[i];
    p.pos = (const int*)d_in[2]; p.out = (float*)d_out; p.ws = (unsigned char*)d_ws;
    static int grid_blocks = 0;
    if (!grid_blocks) {
        int dev = 0, cus = 0, per_cu = 0;
        (void)hipGetDevice(&dev);
        (void)hipDeviceGetAttribute(&cus, hipDeviceAttributeMultiprocessorCount, dev);
        (void)hipFuncSetAttribute((const void*)mega, hipFuncAttributeMaxDynamicSharedMemorySize, LDS_BYTES);
        (void)hipOccupancyMaxActiveBlocksPerMultiprocessor(&per_cu, (const void*)mega, NTHR, LDS_BYTES);
        if (per_cu < 1) per_cu = 1;
        grid_blocks = cus * per_cu;
    }
    (void)hipMemsetAsync((char*)d_ws + WS_CTL, 0, 65536, stream);
    void* args[] = {&p};
    hipError_t e = hipLaunchCooperativeKernel((const void*)mega, dim3(grid_blocks), dim3(NTHR), args, LDS_BYTES, stream);
    if (e != hipSuccess) fprintf(stderr, "cooperative launch failed: %s (grid %d)\n", hipGetErrorString(e), grid_blocks);
}
```
